# Optimizing an MI355X kernel written in HIP

```python
import jax, jax.numpy as jnp
from jax import lax
import numpy as np

D_MODEL = 1024
BATCH = 8
SEQ = 2048
DEPTH = 4

CTX_LEN = 256
GRID_W = 64
N_MIXERS = 3
EPS = 1e-6

A_HEADS = 8
A_DK = 64
A_DV = 128
A_QK = A_HEADS * A_DK
A_V = A_HEADS * A_DV
A_IN = 2 * A_QK + 2 * A_V + 4 * A_HEADS
A_CHUNK = 128
A_CONV = 3
A_FORGET_BIAS = 3.0

B_HEADS = 4
B_DK = D_MODEL // 2 // B_HEADS
B_DV = D_MODEL // B_HEADS
B_QK = B_HEADS * B_DK
B_V = B_HEADS * B_DV
B_RANK = 16
B_TAU = 16.0
B_IN = 2 * B_QK + 2 * B_V + 2 * B_RANK
B_CHUNK = 64

C_HEADS = 16
C_DH = D_MODEL // C_HEADS
C_WIN_ROWS = 8
C_WIN_COLS = 16
C_QBLOCK = 16
C_KSPAN = C_QBLOCK + C_WIN_COLS

FFN_DIM = 2816
FFN_CONV = 3

N_A = (DEPTH + 2) // 3
N_B = (DEPTH + 1) // 3
N_C = DEPTH // 3

kernel_name = "hybrid_mlstm_gla_natten_dit"


def rmsnorm(x, g):
    x32 = x.astype(jnp.float32)
    y = x32 * lax.rsqrt(jnp.mean(x32 * x32, axis=-1, keepdims=True) + EPS)
    return (y * g.astype(jnp.float32)).astype(x.dtype)


def dwconv3(x, w, b):
    xp = jnp.pad(x, ((0, 0), (1, 1), (0, 0)))
    return xp[:, :-2] * w[0] + xp[:, 1:-1] * w[1] + xp[:, 2:] * w[2] + b


def to_heads(x, h):
    b, t, _ = x.shape
    return x.reshape(b, t, h, -1).transpose(0, 2, 1, 3)


def from_heads(x):
    b, h, t, d = x.shape
    return x.transpose(0, 2, 1, 3).reshape(b, t, h * d)


def chunk_seq(x, L):
    b, h, t = x.shape[:3]
    x = x.reshape(b, h, t // L, L, *x.shape[3:])
    return jnp.moveaxis(x, 2, 0)


def unchunk(x):
    x = jnp.moveaxis(x, 0, 2)
    return x.reshape(x.shape[0], x.shape[1], -1, *x.shape[4:])


def mlstm_scan(q, k, v, ig, lf, state):
    L = A_CHUNK
    causal = jnp.tril(jnp.ones((L, L), bool))

    def step(carry, inp):
        C, n, m = carry
        qc, kc, vc, ic, fc = inp
        g = jnp.cumsum(fc, axis=-1)
        logD = jnp.where(causal, g[..., :, None] - g[..., None, :] + ic[..., None, :], -jnp.inf)
        m_inter = g + m[..., None]
        m_row = jnp.maximum(jnp.max(logD, axis=-1), m_inter)
        S = jnp.einsum('bhjd,bhsd->bhjs', qc, kc) * jnp.exp(logD - m_row[..., None])
        inter = jnp.exp(m_inter - m_row)
        num = jnp.einsum('bhjs,bhse->bhje', S, vc) + inter[..., None] * jnp.einsum('bhjd,bhde->bhje', qc, C)
        den = jnp.sum(S, axis=-1) + inter * jnp.einsum('bhjd,bhd->bhj', qc, n)
        h = num / jnp.maximum(jnp.abs(den), jnp.exp(-m_row))[..., None]
        gL = g[..., -1]
        logw = gL[..., None] - g + ic
        m_new = jnp.maximum(gL + m, jnp.max(logw, axis=-1))
        w = jnp.exp(logw - m_new[..., None])
        decay = jnp.exp(gL + m - m_new)
        C_new = decay[..., None, None] * C + jnp.einsum('bhs,bhsd,bhse->bhde', w, kc, vc)
        n_new = decay[..., None] * n + jnp.einsum('bhs,bhsd->bhd', w, kc)
        return (C_new, n_new, m_new), h

    xs = tuple(chunk_seq(t, L) for t in (q, k, v, ig, lf))
    state, h = lax.scan(step, state, xs)
    return unchunk(h), state


def gla_scan(q, k, v, g, S):
    L = B_CHUNK
    causal = jnp.tril(jnp.ones((L, L), bool))[..., None]

    def step(S, inp):
        qc, kc, vc, gc = inp
        G = jnp.cumsum(gc, axis=2)
        Dm = jnp.exp(jnp.where(causal, G[:, :, :, None, :] - G[:, :, None, :, :], -jnp.inf))
        A = jnp.einsum('bhjd,bhsd,bhjsd->bhjs', qc, kc, Dm)
        o = jnp.einsum('bhjs,bhse->bhje', A, vc) + jnp.einsum('bhjd,bhde->bhje', qc * jnp.exp(G), S)
        GL = G[:, :, -1]
        S_new = jnp.exp(GL)[..., None] * S + jnp.einsum('bhsd,bhse->bhde', kc * jnp.exp(GL[:, :, None] - G), vc)
        return S_new, o

    xs = tuple(chunk_seq(t, L) for t in (q, k, v, g))
    S, o = lax.scan(step, S, xs)
    return unchunk(o), S


def bidir_scan(scan_fn, ctx_f, lat_f, ctx_b, lat_b, state0):
    rev = lambda xs: tuple(jnp.flip(t, 2) for t in xs)
    hc_f, st = scan_fn(*ctx_f, state0)
    hl_f, _ = scan_fn(*lat_f, st)
    hc_b, st = scan_fn(*rev(ctx_b), state0)
    hl_b, _ = scan_fn(*rev(lat_b), st)
    return hc_f + jnp.flip(hc_b, 2), hl_f + jnp.flip(hl_b, 2)


def mixer_mlstm(h_ctx, h_lat, w_in, b_gate, conv_w, conv_b, w_out, ctx_out):
    def project(h):
        p = h @ w_in
        qk, v, o, gates = jnp.split(p, [2 * A_QK, 2 * A_QK + A_V, 2 * A_QK + 2 * A_V], axis=-1)
        qk = jax.nn.silu(dwconv3(qk, conv_w, conv_b))
        q, k = jnp.split(qk, 2, axis=-1)
        q = to_heads(q, A_HEADS).astype(jnp.float32) * (A_DK ** -0.5)
        k = to_heads(k, A_HEADS).astype(jnp.float32)
        v = to_heads(v, A_HEADS).astype(jnp.float32)
        b, t, _ = gates.shape
        g = (gates + b_gate).astype(jnp.float32).reshape(b, t, 4, A_HEADS).transpose(2, 0, 3, 1)
        fwd = (q, k, v, g[0], jax.nn.log_sigmoid(g[1]))
        bwd = (q, k, v, g[2], jax.nn.log_sigmoid(g[3]))
        return fwd, bwd, o

    cf, cb, o_c = project(h_ctx)
    lf, lb, o_l = project(h_lat)
    bn = h_lat.shape[0]
    state0 = (jnp.zeros((bn, A_HEADS, A_DK, A_DV), jnp.float32),
              jnp.zeros((bn, A_HEADS, A_DK), jnp.float32),
              jnp.zeros((bn, A_HEADS), jnp.float32))
    hc, hl = bidir_scan(mlstm_scan, cf, lf, cb, lb, state0)

    def out(hh, o):
        return (from_heads(hh).astype(o.dtype) * jax.nn.sigmoid(o)) @ w_out

    return (out(hc, o_c) if ctx_out else None), out(hl, o_l)


def mixer_gla(h_ctx, h_lat, w_in, w_a2, b_a, norm_g, w_out, ctx_out):
    def project(h):
        p = h @ w_in
        q, k, v, r, a = jnp.split(p, [B_QK, 2 * B_QK, 2 * B_QK + B_V, 2 * B_QK + 2 * B_V], axis=-1)
        q = to_heads(q, B_HEADS).astype(jnp.float32) * (B_DK ** -0.5)
        k = to_heads(k, B_HEADS).astype(jnp.float32)
        v = to_heads(v, B_HEADS).astype(jnp.float32)
        a = a.astype(jnp.float32)

        def decay(d):
            z = a[..., d * B_RANK:(d + 1) * B_RANK] @ w_a2[d].astype(jnp.float32) + b_a[d].astype(jnp.float32)
            return to_heads(jax.nn.log_sigmoid(z) / B_TAU, B_HEADS)

        return (q, k, v, decay(0)), (q, k, v, decay(1)), r

    cf, cb, r_c = project(h_ctx)
    lf, lb, r_l = project(h_lat)
    bn = h_lat.shape[0]
    state0 = jnp.zeros((bn, B_HEADS, B_DK, B_DV), jnp.float32)
    oc, ol = bidir_scan(gla_scan, cf, lf, cb, lb, state0)

    def out(oo, r):
        oo = oo * lax.rsqrt(jnp.mean(oo * oo, axis=-1, keepdims=True) + EPS) * norm_g.astype(jnp.float32)
        return (from_heads(oo).astype(r.dtype) * jax.nn.silu(r)) @ w_out

    return (out(oc, r_c) if ctx_out else None), out(ol, r_l)


def mixer_na(h_ctx, h_lat, w_in, rpb, w_out, ctx_out):
    bn, T, _ = h_lat.shape
    rows = T // GRID_W
    kr = min(C_WIN_ROWS, rows)
    scale = C_DH ** -0.5
    q_l, k_l, v_l = [t.reshape(bn, T, C_HEADS, C_DH) for t in jnp.split(h_lat @ w_in, 3, axis=-1)]
    q_c, k_c, v_c = [t.reshape(bn, -1, C_HEADS, C_DH) for t in jnp.split(h_ctx @ w_in, 3, axis=-1)]
    q_l = q_l * scale
    q_c = q_c * scale

    n_cb = GRID_W // C_QBLOCK
    col_q = np.arange(GRID_W).reshape(n_cb, C_QBLOCK)
    k_start = np.clip(np.arange(n_cb) * C_QBLOCK - C_WIN_COLS // 2, 0, GRID_W - C_KSPAN)
    col_k = k_start[:, None] + np.arange(C_KSPAN)
    c_start = np.clip(col_q - C_WIN_COLS // 2, 0, GRID_W - C_WIN_COLS)
    col_valid = (col_k[:, None, :] >= c_start[:, :, None]) & (col_k[:, None, :] < c_start[:, :, None] + C_WIN_COLS)
    dc = np.clip(col_k[:, None, :] - col_q[:, :, None] + C_WIN_COLS - 1, 0, 2 * C_WIN_COLS - 2)

    q_g = q_l.reshape(bn, rows, n_cb, C_QBLOCK, C_HEADS, C_DH)
    k_cols = k_l.reshape(bn, rows, GRID_W, C_HEADS, C_DH)[:, :, col_k]
    v_cols = v_l.reshape(bn, rows, GRID_W, C_HEADS, C_DH)[:, :, col_k]
    n_loc = kr * C_KSPAN

    def row_fn(r):
        rs = jnp.clip(r - kr // 2, 0, rows - kr)
        qr = lax.dynamic_index_in_dim(q_g, r, axis=1, keepdims=False)
        kw = lax.dynamic_slice_in_dim(k_cols, rs, kr, axis=1)
        vw = lax.dynamic_slice_in_dim(v_cols, rs, kr, axis=1)
        s_loc = jnp.einsum('bnqhd,brnkhd->bhnqrk', qr, kw).astype(jnp.float32)
        dr = rs + jnp.arange(kr) - r + (C_WIN_ROWS - 1)
        bias = rpb[:, dr[None, None, :, None], dc[:, :, None, :]].astype(jnp.float32)
        s_loc = jnp.where(col_valid[:, :, None, :], s_loc + bias, -jnp.inf)
        s_ctx = jnp.einsum('bnqhd,bjhd->bhnqj', qr, k_c).astype(jnp.float32)
        s = jnp.concatenate([s_loc.reshape(bn, C_HEADS, n_cb, C_QBLOCK, n_loc), s_ctx], axis=-1)
        p = jax.nn.softmax(s, axis=-1).astype(vw.dtype)
        p_loc = p[..., :n_loc].reshape(bn, C_HEADS, n_cb, C_QBLOCK, kr, C_KSPAN)
        o = (jnp.einsum('bhnqrk,brnkhd->bnqhd', p_loc, vw)
             + jnp.einsum('bhnqj,bjhd->bnqhd', p[..., n_loc:], v_c))
        return o.reshape(bn, GRID_W, C_HEADS, C_DH)

    o = lax.map(row_fn, jnp.arange(rows))
    y_lat = jnp.moveaxis(o, 0, 1).reshape(bn, T, D_MODEL) @ w_out
    y_ctx = None
    if ctx_out:
        s = jnp.einsum('bihd,bjhd->bhij', q_c, k_c).astype(jnp.float32)
        p = jax.nn.softmax(s, axis=-1).astype(v_c.dtype)
        y_ctx = jnp.einsum('bhij,bjhd->bihd', p, v_c).reshape(bn, -1, D_MODEL) @ w_out
    return y_ctx, y_lat


def conv_ffn(h, w_up, conv_w, conv_b, w_down):
    u = dwconv3(h @ w_up, conv_w, conv_b)
    a, g = jnp.split(u, 2, axis=-1)
    return (jax.nn.silu(g) * a) @ w_down


def setup_inputs(seed: int = 0) -> dict:
    key = jax.random.key(seed)
    ks = jax.random.split(key, 32)
    D = D_MODEL
    nrm = lambda k, shape, s: jax.random.normal(k, shape, jnp.float32) * s
    forget_off = jnp.tile(jnp.repeat(jnp.array([0.0, A_FORGET_BIAS], jnp.float32), A_HEADS), 2)
    return {
        "x": nrm(ks[0], (BATCH, SEQ, D), 1.0),
        "c": nrm(ks[1], (BATCH, D), 1.0),
        "ctx": nrm(ks[2], (BATCH, CTX_LEN, D), 1.0),
        "c_ctx": nrm(ks[3], (D,), 1.0),
        "w_ada": nrm(ks[4], (DEPTH, D, 6 * D), 0.5 * D ** -0.5),
        "b_ada": nrm(ks[5], (DEPTH, 6 * D), 0.02),
        "norm_mix": 1.0 + nrm(ks[6], (DEPTH, D), 0.02),
        "norm_ffn": 1.0 + nrm(ks[7], (DEPTH, D), 0.02),
        "w_up": nrm(ks[8], (DEPTH, D, 2 * FFN_DIM), D ** -0.5),
        "ffn_conv_w": nrm(ks[9], (DEPTH, FFN_CONV, 2 * FFN_DIM), FFN_CONV ** -0.5),
        "ffn_conv_b": nrm(ks[10], (DEPTH, 2 * FFN_DIM), 0.02),
        "w_down": nrm(ks[11], (DEPTH, FFN_DIM, D), FFN_DIM ** -0.5),
        "a_w_in": nrm(ks[12], (N_A, D, A_IN), D ** -0.5),
        "a_b_gate": nrm(ks[13], (N_A, 4 * A_HEADS), 0.1) + forget_off,
        "a_conv_w": nrm(ks[14], (N_A, A_CONV, 2 * A_QK), A_CONV ** -0.5),
        "a_conv_b": nrm(ks[15], (N_A, 2 * A_QK), 0.02),
        "a_w_out": nrm(ks[16], (N_A, A_V, D), A_V ** -0.5),
        "b_w_in": nrm(ks[17], (N_B, D, B_IN), D ** -0.5),
        "b_w_a2": nrm(ks[18], (N_B, 2, B_RANK, B_QK), B_RANK ** -0.5),
        "b_b_a": nrm(ks[19], (N_B, 2, B_QK), 0.1),
        "b_norm": 1.0 + nrm(ks[20], (N_B, B_DV), 0.02),
        "b_w_out": nrm(ks[21], (N_B, B_V, D), B_V ** -0.5),
        "c_w_in": nrm(ks[22], (N_C, D, 3 * D), D ** -0.5),
        "c_rpb": nrm(ks[23], (N_C, C_HEADS, 2 * C_WIN_ROWS - 1, 2 * C_WIN_COLS - 1), 0.1),
        "c_w_out": nrm(ks[24], (N_C, D, D), D ** -0.5),
        "norm_final": 1.0 + nrm(ks[25], (D,), 0.02),
    }


def reference(x, c, ctx, c_ctx, w_ada, b_ada, norm_mix, norm_ffn, w_up, ffn_conv_w, ffn_conv_b, w_down,
              a_w_in, a_b_gate, a_conv_w, a_conv_b, a_w_out,
              b_w_in, b_w_a2, b_b_a, b_norm, b_w_out,
              c_w_in, c_rpb, c_w_out, norm_final):
    x_lat, x_ctx = x, ctx
    s_lat = jax.nn.silu(c)
    s_ctx = jax.nn.silu(c_ctx)
    for i in range(DEPTH):
        last = i == DEPTH - 1
        m_lat = (s_lat @ w_ada[i] + b_ada[i])[:, None, :]
        m_ctx = s_ctx @ w_ada[i] + b_ada[i]
        sh1, sc1, g1, sh2, sc2, g2 = jnp.split(m_lat, 6, axis=-1)
        csh1, csc1, cg1, csh2, csc2, cg2 = jnp.split(m_ctx, 6, axis=-1)
        h_lat = rmsnorm(x_lat, norm_mix[i]) * (1.0 + sc1) + sh1
        h_ctx = rmsnorm(x_ctx, norm_mix[i]) * (1.0 + csc1) + csh1
        kind, j = i % N_MIXERS, i // N_MIXERS
        if kind == 0:
            y_ctx, y_lat = mixer_mlstm(h_ctx, h_lat, a_w_in[j], a_b_gate[j], a_conv_w[j], a_conv_b[j], a_w_out[j], not last)
        elif kind == 1:
            y_ctx, y_lat = mixer_gla(h_ctx, h_lat, b_w_in[j], b_w_a2[j], b_b_a[j], b_norm[j], b_w_out[j], not last)
        else:
            y_ctx, y_lat = mixer_na(h_ctx, h_lat, c_w_in[j], c_rpb[j], c_w_out[j], not last)
        x_lat = x_lat + g1 * y_lat
        h_lat = rmsnorm(x_lat, norm_ffn[i]) * (1.0 + sc2) + sh2
        x_lat = x_lat + g2 * conv_ffn(h_lat, w_up[i], ffn_conv_w[i], ffn_conv_b[i], w_down[i])
        if not last:
            x_ctx = x_ctx + cg1 * y_ctx
            h_ctx = rmsnorm(x_ctx, norm_ffn[i]) * (1.0 + csc2) + csh2
            x_ctx = x_ctx + cg2 * conv_ffn(h_ctx, w_up[i], ffn_conv_w[i], ffn_conv_b[i], w_down[i])
    return rmsnorm(x_lat, norm_final)
```

```cpp
#include <hip/hip_runtime.h>
#include <cstdio>
#include <cstdint>
namespace pg8 {
#define PG8_LAS __attribute__((address_space(3)))
typedef unsigned short bf16_t;
typedef short bf16x8 __attribute__((ext_vector_type(8)));
typedef float f32x4 __attribute__((ext_vector_type(4)));
typedef unsigned u32x4 __attribute__((ext_vector_type(4)));
constexpr int BM = 256, BK = 64, HALF = 128, HTB = HALF * BK * 2  , STAGE_BYTES = 8 * HTB, NXCD = 8, WGM = 8;

__host__ __device__ __forceinline__ int lds_byte(int r, int c) { const int st = (r >> 4) * 2 + (c >> 5), rr = r & 15, cc = c & 31, ob = rr * 64 + cc * 2; return st * 1024 + (ob ^ (((ob >> 9) & 1) << 5)); }
__host__ __device__ __forceinline__ void stage_rc(int b, int& R, int& C) { const int st = b / 1024, sb = b % 1024, swz = sb ^ (((sb >> 9) & 1) << 5); R = (st >> 1) * 16 + swz / 64; C = (st & 1) * 32 + (swz % 64) / 2; }
__host__ __device__ __forceinline__ int perm32(int rho) { const int n = rho >> 4, i = rho & 15; return 8 * (i >> 2) + 4 * n + (i & 3); }

struct Unit { int pm, pn, k0, nt; };
struct Gemm { const bf16_t* A; const bf16_t* Bt; int M, N, K; };

struct StaticOrder {
    int nM, nN, nwg, G, c, ntK, wid;
    __host__ __device__ void init(int M, int N, int G_, int c_) { nM = M / BM; nN = N / BM; nwg = nM * nN; G = G_; c = c_; }
    __host__ __device__ bool next(int i, Unit& u) const {
        const long L = (long)i * G + c; if (L >= nwg) return false;
        int wgid = (int)L; { const int q = nwg / NXCD, r = nwg % NXCD, xcd = wgid % NXCD, off = wgid / NXCD; wgid = (xcd < r ? xcd * (q + 1) : r * (q + 1) + (xcd - r) * q) + off; }
        const int nig = WGM * nN, gid = wgid / nig, fm = gid * WGM, gsz = (nM - fm) < WGM ? (nM - fm) : WGM;
        u.pm = fm + ((wgid % nig) % gsz); u.pn = (wgid % nig) / gsz; u.k0 = 0; u.nt = ntK; return true;
    }
    __device__ __forceinline__ void a_ready(const Unit&) const {}
    __device__ __forceinline__ void done(const Unit&) const {}
};


__device__ __forceinline__ unsigned cvt_pk_bf16(float lo, float hi) { unsigned r; asm volatile("v_cvt_pk_bf16_f32 %0, %1, %2" : "=v"(r) : "v"(lo), "v"(hi)); return r; }

template <class Epi, class Sched, bool ALIGN_EPI = false, bool SP2 = false, bool SWAP = false>
__device__ __forceinline__ void gemm_phase(PG8_LAS unsigned char* lds, const Gemm g, const Sched& S, const Epi& E) {
    const int wid = S.wid, wr = wid >> 2, wc = wid & 3;
    const int K = g.K; int nt;
    const size_t kstep = (size_t)(BK * 2);
    const size_t hstep = (size_t)HALF * K * 2;
    const size_t tstep = 2 * hstep;
    const unsigned ldsw = (unsigned)wid * 1024u;
    int tid, lane, fr, fq, aoff, boff; unsigned voffA[2], voffB[2];
#define PG8_LANE_SETUP() do { int l_; asm volatile("v_mbcnt_lo_u32_b32 %0, -1, 0\n\tv_mbcnt_hi_u32_b32 %0, -1, %0" : "=v"(l_)); lane = l_; tid = wid * 64 + l_; fr = lane & 15; fq = lane >> 4; \
        _Pragma("unroll") for (int i_ = 0; i_ < 2; ++i_) { int R, C; stage_rc(tid * 16 + i_ * 8192, R, C); const int Rb = Epi::PERM ? ((R & ~31) + perm32(R & 31)) : R; \
            voffA[i_] = (unsigned)(R * K + C) * 2u; voffB[i_] = (unsigned)(Rb * K + C) * 2u; } \
        aoff = lds_byte(wr * 64 + fr, fq * 8); boff = lds_byte(wc * 32 + fr, fq * 8); } while (0)
    PG8_LANE_SETUP();
#define PG8_SA(b, h) (((b) * 2 + (h)) * HTB)
#define PG8_SB(b, h) ((4 + (b) * 2 + (h)) * HTB)
#define PG8_STAGE(bufoff, gbase, voff) do { _Pragma("unroll") for (int _i = 0; _i < 2; ++_i) \
        __builtin_amdgcn_global_load_lds((const unsigned*)((const char*)(gbase) + (voff)[_i]), (PG8_LAS unsigned*)(lds + (bufoff) + ldsw + _i * 8192), 16, 0, 0); } while (0)
#define PG8_LDA(dst, b, h) do { _Pragma("unroll") for (int m = 0; m < 4; ++m) _Pragma("unroll") for (int k = 0; k < 2; ++k) dst[m][k] = *(const PG8_LAS bf16x8*)(lds + PG8_SA(b, h) + aoff + m * 2048 + k * 1024); } while (0)
#define PG8_LDB(dst, b, h) do { _Pragma("unroll") for (int n = 0; n < 2; ++n) _Pragma("unroll") for (int k = 0; k < 2; ++k) dst[n][k] = *(const PG8_LAS bf16x8*)(lds + PG8_SB(b, h) + boff + n * 2048 + k * 1024); } while (0)
#define PG8_MMA(ai, bj, At, Bt) do { __builtin_amdgcn_s_setprio(1); _Pragma("unroll") for (int m = 0; m < 4; ++m) _Pragma("unroll") for (int n = 0; n < 2; ++n) _Pragma("unroll") for (int k = 0; k < 2; ++k) \
        acc[ai][bj][m][n] = SWAP ? __builtin_amdgcn_mfma_f32_16x16x32_bf16(At[m][k], Bt[n][k], acc[ai][bj][m][n], 0, 0, 0) : __builtin_amdgcn_mfma_f32_16x16x32_bf16(Bt[n][k], At[m][k], acc[ai][bj][m][n], 0, 0, 0); __builtin_amdgcn_s_setprio(0); } while (0)
#define PG8_WAIT_V(n) asm volatile("s_waitcnt vmcnt(" #n ")" ::: "memory")
#define PG8_WAIT_L(n) asm volatile("s_waitcnt lgkmcnt(" #n ")" ::: "memory")
#define PG8_BAR __builtin_amdgcn_s_barrier()
#define PG8_SCHED __builtin_amdgcn_sched_barrier(0)
    Unit cur, nxt; int ui = 0;
    if (!S.next(0, cur)) return;
    nt = cur.nt;
    f32x4 acc[2][2][4][2];
#pragma unroll
    for (int a = 0; a < 2; ++a)
#pragma unroll
        for (int b = 0; b < 2; ++b)
#pragma unroll
            for (int m = 0; m < 4; ++m)
#pragma unroll
                for (int n = 0; n < 2; ++n) acc[a][b][m][n] = (f32x4){0.f, 0.f, 0.f, 0.f};
    bf16x8 At[4][2], B0[2][2], B1[2][2];
    const char* cA = (const char*)g.A + (size_t)cur.pm * tstep + (size_t)cur.k0 * 2; const char* cB = (const char*)g.Bt + (size_t)cur.pn * tstep + (size_t)cur.k0 * 2;
    S.a_ready(cur);
    if constexpr (SP2) {
        PG8_STAGE(PG8_SB(0, 0), cB, voffB); PG8_STAGE(PG8_SB(0, 1), cB + hstep, voffB); PG8_STAGE(PG8_SA(0, 0), cA, voffA); PG8_STAGE(PG8_SA(0, 1), cA + hstep, voffA);
        if (wr == 1) PG8_BAR;
        PG8_WAIT_V(2); PG8_BAR;
        PG8_STAGE(PG8_SB(1, 0), cB + kstep, voffB); PG8_STAGE(PG8_SA(1, 0), cA + kstep, voffA); PG8_STAGE(PG8_SB(1, 1), cB + hstep + kstep, voffB);
        PG8_WAIT_V(6); PG8_BAR;
    } else {
        PG8_STAGE(PG8_SB(0, 0), cB, voffB); PG8_STAGE(PG8_SA(0, 0), cA, voffA); PG8_STAGE(PG8_SB(0, 1), cB + hstep, voffB); PG8_STAGE(PG8_SA(0, 1), cA + hstep, voffA);
        if (wr == 1) PG8_BAR;
        PG8_WAIT_V(4); PG8_BAR;
        PG8_STAGE(PG8_SB(1, 0), cB + kstep, voffB); PG8_STAGE(PG8_SA(1, 0), cA + kstep, voffA); PG8_STAGE(PG8_SB(1, 1), cB + hstep + kstep, voffB);
        PG8_WAIT_V(6); PG8_BAR;
    }
    for (;;) {
        const bool has_next = S.next(ui + 1, nxt);
        const char* nA = has_next ? (const char*)g.A + (size_t)nxt.pm * tstep + (size_t)nxt.k0 * 2 : cA; const char* nB = has_next ? (const char*)g.Bt + (size_t)nxt.pn * tstep + (size_t)nxt.k0 * 2 : cB;
        for (int t = 0; t < nt; t += 2) {
            const bool last = (t == nt - 2);
            const char* a1 = cA + (size_t)(t + 1) * kstep;
            const char* a2 = last ? nA : cA + (size_t)(t + 2) * kstep; const char* b2 = last ? nB : cB + (size_t)(t + 2) * kstep;
            const char* a3 = a2 + kstep; const char* b3 = b2 + kstep;
            if (last && has_next) S.a_ready(nxt);
            if constexpr (SP2) {
            PG8_LDB(B0, 0, 0); PG8_LDB(B1, 0, 1); PG8_SCHED; PG8_LDA(At, 0, 0); PG8_STAGE(PG8_SA(1, 1), a1 + hstep, voffA);
            PG8_WAIT_V(8); PG8_WAIT_L(0); PG8_BAR; PG8_MMA(0, 0, At, B0); PG8_MMA(0, 1, At, B1); PG8_BAR; PG8_SCHED;
            PG8_LDA(At, 0, 1); PG8_STAGE(PG8_SB(0, 0), b2, voffB); PG8_STAGE(PG8_SB(0, 1), b2 + hstep, voffB); PG8_STAGE(PG8_SA(0, 0), a2, voffA);
            PG8_WAIT_V(8); PG8_WAIT_L(0); PG8_BAR; PG8_MMA(1, 0, At, B0); PG8_MMA(1, 1, At, B1); PG8_BAR; PG8_SCHED;
            PG8_LDB(B0, 1, 0); PG8_LDB(B1, 1, 1); PG8_SCHED; PG8_LDA(At, 1, 0); PG8_STAGE(PG8_SA(0, 1), a2 + hstep, voffA);
            PG8_WAIT_V(8); PG8_WAIT_L(0); PG8_BAR; PG8_MMA(0, 0, At, B0); PG8_MMA(0, 1, At, B1); PG8_BAR; PG8_SCHED;
            PG8_LDA(At, 1, 1); PG8_STAGE(PG8_SB(1, 0), b3, voffB); PG8_STAGE(PG8_SB(1, 1), b3 + hstep, voffB); PG8_STAGE(PG8_SA(1, 0), a3, voffA);
            PG8_WAIT_V(8); PG8_WAIT_L(0); PG8_BAR; PG8_MMA(1, 0, At, B0); PG8_MMA(1, 1, At, B1); PG8_BAR; PG8_SCHED;
            } else {
            PG8_LDB(B0, 0, 0); PG8_SCHED; PG8_LDA(At, 0, 0); PG8_STAGE(PG8_SA(1, 1), a1 + hstep, voffA);
            PG8_WAIT_L(8); PG8_BAR; PG8_WAIT_L(0); PG8_MMA(0, 0, At, B0); PG8_BAR; PG8_SCHED;
            PG8_LDB(B1, 0, 1); PG8_STAGE(PG8_SB(0, 0), b2, voffB);
            PG8_BAR; PG8_WAIT_L(0); PG8_MMA(0, 1, At, B1); PG8_BAR;
            PG8_LDA(At, 0, 1); PG8_STAGE(PG8_SA(0, 0), a2, voffA);
            PG8_BAR; PG8_WAIT_L(0); PG8_MMA(1, 0, At, B0); PG8_BAR; PG8_SCHED;
            PG8_STAGE(PG8_SB(0, 1), b2 + hstep, voffB);
            PG8_WAIT_V(6); PG8_BAR; PG8_MMA(1, 1, At, B1); PG8_BAR;
            PG8_LDB(B0, 1, 0); PG8_SCHED; PG8_LDA(At, 1, 0); PG8_STAGE(PG8_SA(0, 1), a2 + hstep, voffA);
            PG8_WAIT_L(8); PG8_BAR; PG8_WAIT_L(0); PG8_MMA(0, 0, At, B0); PG8_BAR; PG8_SCHED;
            PG8_LDB(B1, 1, 1); PG8_STAGE(PG8_SB(1, 0), b3, voffB);
            PG8_BAR; PG8_WAIT_L(0); PG8_MMA(0, 1, At, B1); PG8_BAR;
            PG8_LDA(At, 1, 1); PG8_STAGE(PG8_SA(1, 0), a3, voffA);
            PG8_BAR; PG8_WAIT_L(0); PG8_MMA(1, 0, At, B0); PG8_BAR; PG8_SCHED;
            PG8_STAGE(PG8_SB(1, 1), b3 + hstep, voffB);
            PG8_WAIT_V(6); PG8_BAR; PG8_MMA(1, 1, At, B1); PG8_BAR;
            }
        }
        if constexpr (ALIGN_EPI) { if (wr == 0) PG8_BAR; }
        if constexpr (!Epi::AFTER_DRAIN) { E(acc, cur, wr, wc, fr, fq); S.done(cur); if constexpr (SWAP) PG8_LANE_SETUP(); }
        if (!has_next) break;
#pragma unroll
        for (int a = 0; a < 2; ++a)
#pragma unroll
            for (int b = 0; b < 2; ++b)
#pragma unroll
                for (int m = 0; m < 4; ++m)
#pragma unroll
                    for (int n = 0; n < 2; ++n) acc[a][b][m][n] = (f32x4){0.f, 0.f, 0.f, 0.f};
        cur = nxt; cA = nA; cB = nB; nt = cur.nt; ++ui;
        if constexpr (ALIGN_EPI) { if (wr == 1) PG8_BAR; }
    }
    PG8_WAIT_V(0);
    if constexpr (!ALIGN_EPI) { if (wr == 0) PG8_BAR; }
    PG8_BAR;
    if constexpr (Epi::AFTER_DRAIN) { E.fused(acc, cur, wr, wc, fr, fq, lds, wid, lane); S.done(cur); }
#undef PG8_LANE_SETUP
#undef PG8_SA
#undef PG8_SB
#undef PG8_STAGE
#undef PG8_LDA
#undef PG8_LDB
#undef PG8_MMA
#undef PG8_WAIT_V
#undef PG8_WAIT_L
#undef PG8_BAR
#undef PG8_SCHED
}
}

#define GAS __attribute__((address_space(1)))
#define LAS __attribute__((address_space(3)))
typedef unsigned short bf16;
typedef unsigned v4u __attribute__((ext_vector_type(4)));
typedef unsigned v2u __attribute__((ext_vector_type(2)));
typedef float f32x4 __attribute__((ext_vector_type(4)));
typedef float f32x2 __attribute__((ext_vector_type(2)));
typedef short bf16x8 __attribute__((ext_vector_type(8)));
typedef short bf16x4 __attribute__((ext_vector_type(4)));

constexpr int D = 1024, NB = 8, TL = 2048, TC = 256, DEPTH = 4;
constexpr int ML = NB * TL, MC = NB * TC, MT = ML + MC;
constexpr int FF = 2816, FF2 = 5632;
constexpr int NINP = 3328;
constexpr int PLD = 3072;
constexpr float EPS = 1e-6f;
constexpr int NWAVES = 8, NTHR = 512;

constexpr size_t MiB = 1u << 20;
constexpr size_t WS_CTL = 0, CTL_ZERO_BYTES = 65536;
constexpr size_t WS_MOD = 1 * MiB;
constexpr size_t WS_WB = 2 * MiB;
constexpr size_t WB_LAYER = 25 * MiB, WB_IN = 0, WB_OUT = 6815744, WB_UP = WB_OUT + 2097152, WB_DN = WB_UP + 11534336;
static_assert(WB_DN + 5767168 == WB_LAYER, "weights per layer");
constexpr size_t WS_X = 102 * MiB;
constexpr size_t WS_H16 = 174 * MiB;
constexpr size_t WS_HB16 = 210 * MiB;
constexpr size_t WS_P16 = 246 * MiB;
constexpr size_t WS_G32 = 354 * MiB;
constexpr size_t WS_EDGE = 357 * MiB;
constexpr size_t WS_SCR = 364 * MiB;
constexpr size_t WS_GATES = 372 * MiB;
constexpr size_t WS_SLAB = 138 * MiB;
constexpr size_t WS_EGL = 171 * MiB;
constexpr size_t WS_END = 381 * MiB;

constexpr int LDS_BYTES = 163840;
constexpr int MISC_OFF = LDS_BYTES - 512;
constexpr int CE_OFF = MISC_OFF - 8192;

#define RLX_AGENT __ATOMIC_RELAXED, __HIP_MEMORY_SCOPE_AGENT
#define LDS_WAIT() asm volatile("s_waitcnt lgkmcnt(0)" ::: "memory")
#define VM_WAIT() asm volatile("s_waitcnt vmcnt(0)" ::: "memory")
__device__ __forceinline__ unsigned f2bf(float f) { unsigned u = __builtin_bit_cast(unsigned, f); return (u + 0x7fffu + ((u >> 16) & 1u)) >> 16; }
__device__ __forceinline__ unsigned pk2(float lo, float hi) { return f2bf(lo) | (f2bf(hi) << 16); }
__device__ __forceinline__ unsigned cvtpk(float lo, float hi) { unsigned r; asm("v_cvt_pk_bf16_f32 %0, %1, %2" : "=v"(r) : "v"(lo), "v"(hi)); return r; }
__device__ __forceinline__ float bf2f(unsigned h) { return __builtin_bit_cast(float, h << 16); }
__device__ __forceinline__ float bflo(unsigned w) { return __builtin_bit_cast(float, w << 16); }
__device__ __forceinline__ float bfhi(unsigned w) { return __builtin_bit_cast(float, w & 0xffff0000u); }
__device__ __forceinline__ f32x4 ld4bf(const bf16* q) { const v2u w = *(const v2u*)q; return (f32x4){bflo(w.x), bfhi(w.x), bflo(w.y), bfhi(w.y)}; }
__device__ __forceinline__ void unpk8(const v4u w, float* f) { f[0] = bflo(w.x); f[1] = bfhi(w.x); f[2] = bflo(w.y); f[3] = bfhi(w.y); f[4] = bflo(w.z); f[5] = bfhi(w.z); f[6] = bflo(w.w); f[7] = bfhi(w.w); }
__device__ __forceinline__ v4u pk8(const float* f) { v4u w; w.x = pk2(f[0], f[1]); w.y = pk2(f[2], f[3]); w.z = pk2(f[4], f[5]); w.w = pk2(f[6], f[7]); return w; }
__device__ __forceinline__ void st4bf(bf16* q, f32x4 v) { v2u w; w.x = pk2(v.x, v.y); w.y = pk2(v.z, v.w); *(v2u*)q = w; }
__device__ __forceinline__ v4u cvt8_st(float a0, float a1, float a2, float a3, float a4, float a5, float a6, float a7) {
    v4u p;
    asm volatile("v_cvt_pk_bf16_f32 %0, %4, %5\n\tv_cvt_pk_bf16_f32 %1, %6, %7\n\tv_cvt_pk_bf16_f32 %2, %8, %9\n\tv_cvt_pk_bf16_f32 %3, %10, %11\n\ts_nop 0"
                 : "=&v"(p.x), "=&v"(p.y), "=&v"(p.z), "=&v"(p.w) : "v"(a0), "v"(a1), "v"(a2), "v"(a3), "v"(a4), "v"(a5), "v"(a6), "v"(a7));
    return p;
}
__device__ __forceinline__ float sigmoidf_(float x) { return __builtin_amdgcn_rcpf(1.0f + __expf(-x)); }
__device__ __forceinline__ float siluf_(float x) { return x * sigmoidf_(x); }
__device__ __forceinline__ float logsigmoidf_(float x) { return fminf(x, 0.f) - log1pf(__expf(-fabsf(x))); }
__device__ __forceinline__ int lane_id_now() { int l; asm volatile("v_mbcnt_lo_u32_b32 %0, -1, 0\n\tv_mbcnt_hi_u32_b32 %0, -1, %0" : "=v"(l)); return l; }
__device__ __forceinline__ float wave_sum(float v) {
#pragma unroll
    for (int o = 1; o < 64; o <<= 1) v += __shfl_xor(v, o);
    return v;
}

#define XB_TMO      128
#define XB_XCNT(j)  (256  + 64 * (j))
#define XB_XSUB(j)  (1280 + 64 * (j))
#define XB_XGEN(j)  (2304 + 64 * (j))
#define XB_TOP      3328
#define XB_TOPGEN   3392
#define XCD_BAR_WORDS 3456
#define XB_SPIN_CAP (1u << 20)
__device__ __forceinline__ unsigned xb_ld(unsigned* p)              { return __hip_atomic_load(p, __ATOMIC_RELAXED, __HIP_MEMORY_SCOPE_AGENT); }
__device__ __forceinline__ unsigned xb_add(unsigned* p, unsigned v) { return __hip_atomic_fetch_add(p, v, __ATOMIC_RELAXED, __HIP_MEMORY_SCOPE_AGENT); }
__device__ __forceinline__ unsigned xb_xcc_id() { return (unsigned)__builtin_amdgcn_s_getreg((3 << 11) | 20) & 0xFu; }
#define XB_SPIN(cond, bar) do { unsigned _sp = 0; while (cond) { __builtin_amdgcn_s_sleep(1); \
    if ((++_sp & 255u) == 0u) { if (xb_ld(&(bar)[XB_TMO])) break; if (_sp > XB_SPIN_CAP) { atomicAdd(&(bar)[XB_TMO], 1u); break; } } } } while (0)
struct XcdBarrier { unsigned* bar; unsigned x; volatile LAS unsigned* st; bool lead; };
__device__ __forceinline__ XcdBarrier xcd_barrier_post(unsigned* bar, volatile LAS unsigned* st, bool lead0) {
    XcdBarrier b; b.bar = bar; b.x = xb_xcc_id(); b.st = st; b.lead = lead0;
    if (b.lead && lane_id_now() == 0) (void)xb_add(&bar[XB_XCNT(b.x)], 1u);
    return b;
}
__device__ __forceinline__ void xcd_barrier_complete(unsigned* bar, unsigned x, unsigned& nloc, unsigned& nx) {
    const unsigned G = gridDim.x * gridDim.y * gridDim.z;
    unsigned sum, cnt, mine, sp = 0u;
    for (;;) {
        sum = 0u; cnt = 0u; mine = 0u;
#pragma unroll
        for (unsigned j = 0; j < 16; ++j) { const unsigned c = xb_ld(&bar[XB_XCNT(j)]); sum += c; cnt += (c > 0u) ? 1u : 0u; mine = (j == x) ? c : mine; }
        if (sum == G) break;
        __builtin_amdgcn_s_sleep(1);
        if ((++sp & 255u) == 0u) { if (xb_ld(&bar[XB_TMO])) break; if (sp > XB_SPIN_CAP) { atomicAdd(&bar[XB_TMO], 1u); break; } }
    }
    nloc = mine > 0u ? mine : 1u; nx = cnt > 0u ? cnt : 1u;
}
__device__ __forceinline__ void xcd_barrier(const XcdBarrier& b) {
    asm volatile("s_waitcnt vmcnt(0)" ::: "memory");
    __syncthreads();
    if (b.lead && lane_id_now() == 0) {
        unsigned* bar = b.bar;
        __builtin_amdgcn_s_waitcnt(0);
        unsigned nloc = b.st[0], nx = b.st[1];
        if (nloc == 0u) { xcd_barrier_complete(bar, b.x, nloc, nx); b.st[0] = nloc; b.st[1] = nx; }
        const unsigned old = xb_add(&bar[XB_XSUB(b.x)], 1u);
        const unsigned gen = old / nloc;
        if (old + 1u == (gen + 1u) * nloc) {
            __builtin_amdgcn_fence(__ATOMIC_RELEASE, "agent");
            asm volatile("s_waitcnt vmcnt(0)" ::: "memory");
            const unsigned og = xb_add(&bar[XB_TOP], 1u);
            const unsigned tg = og / nx;
            if (og + 1u == (tg + 1u) * nx) xb_add(&bar[XB_TOPGEN], 1u);
            else XB_SPIN(xb_ld(&bar[XB_TOPGEN]) == tg, bar);
            __builtin_amdgcn_fence(__ATOMIC_ACQUIRE, "agent");
            xb_add(&bar[XB_XGEN(b.x)], 1u);
            asm volatile("s_waitcnt vmcnt(0)" ::: "memory");
        } else {
            XB_SPIN(xb_ld(&bar[XB_XGEN(b.x)]) == gen, bar);
            __builtin_amdgcn_fence(__ATOMIC_ACQUIRE, "agent");
            asm volatile("s_waitcnt vmcnt(0)" ::: "memory");
        }
    }
    __syncthreads();
}

#define GB_CNT(g) (4096 + 64 * (g))
#define GB_GEN(g) (4096 + 512 + 64 * (g))
#define FL_W(l)   (4096 + 1024 + 64 * (l))
#define FL_M(l)   (4096 + 1536 + 64 * (l))
#define GB_XID(v) (6144 + (v))
__device__ __forceinline__ void grp_barrier(unsigned* bar, int g, unsigned& ph, int tid, bool same_l2) {
    asm volatile("s_waitcnt vmcnt(0)" ::: "memory");
    __syncthreads();
    if (tid == 0) {
        if (!same_l2) __builtin_amdgcn_fence(__ATOMIC_RELEASE, "agent");
        const unsigned old = xb_add(&bar[GB_CNT(g)], 1u);
        if (old + 1u == 32u * (ph + 1u)) { __hip_atomic_store(&bar[GB_GEN(g)], ph + 1u, __ATOMIC_RELAXED, __HIP_MEMORY_SCOPE_AGENT); }
        else XB_SPIN(xb_ld(&bar[GB_GEN(g)]) < ph + 1u, bar);
        __builtin_amdgcn_fence(__ATOMIC_ACQUIRE, "agent");
    }
    ph += 1u;
    __syncthreads();
}
__device__ __forceinline__ void flag_signal(unsigned* bar, int word, int tid) {
    asm volatile("s_waitcnt vmcnt(0)" ::: "memory");
    __syncthreads();
    if (tid == 0) { __builtin_amdgcn_fence(__ATOMIC_RELEASE, "agent"); xb_add(&bar[word], 1u); }
}
__device__ __forceinline__ void flag_wait(unsigned* bar, int word, unsigned n, int tid) {
    if (tid == 0) { XB_SPIN(xb_ld(&bar[word]) < n, bar); __builtin_amdgcn_fence(__ATOMIC_ACQUIRE, "agent"); }
    __syncthreads();
}

struct Args { const float* in[26]; float* out; unsigned char* ws; int ph_lo, ph_hi; };
struct Frame {
    LAS unsigned char* lds;
    int tid, lane, wave, vcu, G;
    int grp, mi; unsigned gph; bool same_l2;
    unsigned char* ws;
    bf16* X; bf16* H16; bf16* HB16; bf16* P16; float* G32; float* EDGE; float* MOD;
};
__device__ __forceinline__ int grow(const Frame& F, int lr) { return lr < TL ? F.grp * TL + lr : ML + F.grp * TC + (lr - TL); }
__device__ __forceinline__ bf16* wb_ptr(const Frame& F, int layer, size_t off) { return (bf16*)(F.ws + WS_WB + (size_t)layer * WB_LAYER + off); }

__device__ __forceinline__ void p0_transpose_item(const float* W, int K, int N, bf16* WT, int k0, int n0, int drow0, LAS float* scr, int lane) {
    float wv[32];
#pragma unroll
    for (int i = 0; i < 32; ++i) { const int kk = 2 * i + (lane >> 5); wv[i] = W[(size_t)(k0 + kk) * N + n0 + (lane & 31)]; }
#pragma unroll
    for (int i = 0; i < 32; ++i) { const int kk = 2 * i + (lane >> 5); scr[kk * 33 + (lane & 31)] = wv[i]; }
    LDS_WAIT(); asm volatile("" ::: "memory");
    const int c = lane & 7;
#pragma unroll
    for (int j = 0; j < 4; ++j) { const int n = (lane >> 3) + 8 * j; const LAS float* s = scr + (8 * c) * 33 + n;
        v4u o; o.x = pk2(s[0 * 33], s[1 * 33]); o.y = pk2(s[2 * 33], s[3 * 33]); o.z = pk2(s[4 * 33], s[5 * 33]); o.w = pk2(s[6 * 33], s[7 * 33]);
        *(GAS v4u*)(WT + (size_t)(drow0 + n) * K + k0 + 8 * c) = o; }
    LDS_WAIT(); asm volatile("" ::: "memory");
}
__device__ __forceinline__ int up_row_map(int n) {
    const int g = n >= FF ? 1 : 0, c = n - g * FF;
    return (c >> 7) * 256 + g * 128 + (c & 127);
}
__device__ __forceinline__ void convert_layer_weights(Frame& F, const Args& A, int layer, int widx, int nw) {
    LAS float* scr = (LAS float*)(F.lds + F.wave * 8704);
    const int kind = layer % 3, j = layer / 3;
    const float* Win = kind == 0 ? A.in[12] + (size_t)j * D * 3104 : (kind == 1 ? A.in[17] : A.in[22]);
    const int Nin = kind == 2 ? 3072 : 3104;
    const float* Wout = kind == 0 ? A.in[16] + (size_t)j * D * D : (kind == 1 ? A.in[21] : A.in[24]);
    const float* Wup = A.in[8] + (size_t)layer * D * FF2;
    const float* Wdn = A.in[11] + (size_t)layer * FF * D;
    bf16* Tin = wb_ptr(F, layer, WB_IN); bf16* Tout = wb_ptr(F, layer, WB_OUT); bf16* Tup = wb_ptr(F, layer, WB_UP); bf16* Tdn = wb_ptr(F, layer, WB_DN);
    const int nb_in = Nin / 32, I_in = 16 * nb_in, I_out = 16 * 32, I_up = 16 * 176, I_dn = 44 * 32;
    const int NIT = I_in + I_out + I_up + I_dn;
    for (int it = widx; it < NIT; it += nw) {
        int r = it;
        if (r < I_in) { const int kb = r / nb_in, nb = r % nb_in; p0_transpose_item(Win, D, Nin, Tin, 64 * kb, 32 * nb, 32 * nb, scr, F.lane); continue; } r -= I_in;
        if (r < I_out) { const int kb = r / 32, nb = r % 32; p0_transpose_item(Wout, D, D, Tout, 64 * kb, 32 * nb, 32 * nb, scr, F.lane); continue; } r -= I_out;
        if (r < I_up) { const int kb = r / 176, nb = r % 176; p0_transpose_item(Wup, D, FF2, Tup, 64 * kb, 32 * nb, up_row_map(32 * nb), scr, F.lane); continue; } r -= I_up;
        { const int kb = r / 32, nb = r % 32; p0_transpose_item(Wdn, FF, D, Tdn, 64 * kb, 32 * nb, 32 * nb, scr, F.lane); }
    }
    if (kind != 2) {
        const int nz = (NINP - 3104) * D / 8;
        GAS v4u* z = (GAS v4u*)(Tin + (size_t)3104 * D);
        unsigned z_ = 0u; asm volatile("" : "+v"(z_));
        for (int i = widx * 64 + F.lane; i < nz; i += nw * 64) z[i] = (v4u){z_, z_, z_, z_};
    }
}
__device__ __forceinline__ void p0_adaln(Frame& F, const Args& A, int layer, int widx, int nw) {
    LAS float* sv = (LAS float*)(F.lds + 73728);
    LAS float* red = (LAS float*)(F.lds + 73728 + 36864);
    __syncthreads();
    for (int i = F.tid; i < 9 * D; i += NTHR) { const int r = i >> 10, k = i & 1023; const float c = r < 8 ? A.in[1][r * D + k] : A.in[3][k]; sv[i] = siluf_(c); }
    __syncthreads();
    const int col = F.lane & 31, kp = F.lane >> 5;
    for (int task = widx; task < 192; task += nw) {
        const int n0 = task * 32;
        const float* W = A.in[4] + (size_t)layer * D * 6144 + n0 + col;
        float acc[9];
#pragma unroll
        for (int r = 0; r < 9; ++r) acc[r] = 0.f;
        const int kbase = F.wave * 128 + kp;
#pragma unroll
        for (int ib = 0; ib < 2; ++ib) {
            float wv[32];
#pragma unroll
            for (int i = 0; i < 32; ++i) wv[i] = W[(size_t)(kbase + 2 * (ib * 32 + i)) * 6144];
#pragma unroll
            for (int i = 0; i < 32; ++i) { const int k = kbase + 2 * (ib * 32 + i);
#pragma unroll
                for (int r = 0; r < 9; ++r) acc[r] += sv[r * D + k] * wv[i]; }
        }
#pragma unroll
        for (int r = 0; r < 9; ++r) red[((F.wave * 2 + kp) * 9 + r) * 32 + col] = acc[r];
        __syncthreads();
        if (F.tid < 288) { const int r = F.tid >> 5, c2 = F.tid & 31; float s = 0.f;
#pragma unroll
            for (int p2 = 0; p2 < 16; ++p2) s += red[(p2 * 9 + r) * 32 + c2];
            F.MOD[((size_t)layer * 9 + r) * 6144 + n0 + c2] = s + A.in[5][layer * 6144 + n0 + c2]; }
        __syncthreads();
    }
}

__device__ __forceinline__ void norm_phase(Frame& F, const Args& A, int layer, int which, bool first, int nrows, const float* slab, const float* sgate) {
    const int gw = F.mi * NWAVES + F.wave, NGW = 32 * NWAVES, c0 = F.lane * 16;
    nrows = nrows == MT ? TL + TC : TL;
    const float* gam = (which == 0 ? A.in[6] : A.in[7]) + layer * D + c0;
    const float* mod = F.MOD + (size_t)layer * 9 * 6144 + (which == 0 ? 0 : 3072) + c0;
    float gv[16];
#pragma unroll
    for (int j = 0; j < 4; ++j) { const f32x4 g = *(const f32x4*)(gam + 4 * j); gv[4 * j] = g.x; gv[4 * j + 1] = g.y; gv[4 * j + 2] = g.z; gv[4 * j + 3] = g.w; }
    for (int rowA = gw; rowA < nrows; rowA += 2 * NGW) {
        const bool vB = rowA + NGW < nrows;
#pragma unroll
        for (int q = 0; q < 2; ++q) {
            if (q == 1 && !vB) break;
            const int row = grow(F, rowA + q * NGW);
            const int r = row < ML ? (row >> 11) : 8;
            float x[16];
            if (first) { const float* src = (row < ML ? A.in[0] + (size_t)row * D : A.in[2] + (size_t)(row - ML) * D) + c0;
#pragma unroll
                for (int j = 0; j < 4; ++j) { const f32x4 t = *(const f32x4*)(src + 4 * j); x[4 * j] = t.x; x[4 * j + 1] = t.y; x[4 * j + 2] = t.z; x[4 * j + 3] = t.w; }
            } else { const bf16* xr = F.X + (size_t)row * D + c0; unpk8(*(const v4u*)xr, x); unpk8(*(const v4u*)(xr + 8), x + 8); }
            const bool sl = slab != nullptr && row >= ML;
            if (sl) {
                const bf16* s16 = (const bf16*)slab + (size_t)(row - ML) * D + c0;
                const int ns = which == 0 ? 8 : 4;
#pragma unroll
                for (int hv = 0; hv < 2; ++hv) { float ps[8];
#pragma unroll
                    for (int i = 0; i < 8; ++i) ps[i] = 0.f;
                    for (int q = 0; q < ns; q += 4) { float p0[8], p1[8], p2[8], p3[8];
                        unpk8(*(const v4u*)(s16 + (size_t)q * MC * D + hv * 8), p0); unpk8(*(const v4u*)(s16 + (size_t)(q + 1) * MC * D + hv * 8), p1);
                        unpk8(*(const v4u*)(s16 + (size_t)(q + 2) * MC * D + hv * 8), p2); unpk8(*(const v4u*)(s16 + (size_t)(q + 3) * MC * D + hv * 8), p3);
#pragma unroll
                        for (int i = 0; i < 8; ++i) ps[i] += (p0[i] + p1[i]) + (p2[i] + p3[i]); }
                    const f32x4 sg0 = *(const f32x4*)(sgate + c0 + hv * 8), sg1 = *(const f32x4*)(sgate + c0 + hv * 8 + 4);
#pragma unroll
                    for (int i = 0; i < 8; ++i) x[hv * 8 + i] += (i < 4 ? sg0[i & 3] : sg1[i & 3]) * ps[i]; }
            }
            float s = 0.f;
#pragma unroll
            for (int i = 0; i < 16; ++i) s += x[i] * x[i];
            if (first || sl) { bf16* xw = F.X + (size_t)row * D + c0; *(v4u*)xw = pk8(x); *(v4u*)(xw + 8) = pk8(x + 8); }
            const float rinv = 1.0f / sqrtf(wave_sum(s) * (1.f / D) + EPS);
            const float* sh = mod + (size_t)r * 6144; const float* sc = sh + 1024;
            float y[16];
#pragma unroll
            for (int j = 0; j < 4; ++j) { const f32x4 a = *(const f32x4*)(sc + 4 * j), bb = *(const f32x4*)(sh + 4 * j);
                y[4 * j] = x[4 * j] * rinv * gv[4 * j] * (a.x + 1.0f) + bb.x; y[4 * j + 1] = x[4 * j + 1] * rinv * gv[4 * j + 1] * (a.y + 1.0f) + bb.y;
                y[4 * j + 2] = x[4 * j + 2] * rinv * gv[4 * j + 2] * (a.z + 1.0f) + bb.z; y[4 * j + 3] = x[4 * j + 3] * rinv * gv[4 * j + 3] * (a.w + 1.0f) + bb.w; }
            bf16* hw = F.H16 + (size_t)row * D + c0; *(v4u*)hw = pk8(y); *(v4u*)(hw + 8) = pk8(y + 8);
        }
    }
}
__device__ __forceinline__ void final_norm_phase(Frame& F, const Args& A) {
    const int gw = F.mi * NWAVES + F.wave, NGW = 32 * NWAVES, c0 = F.lane * 16;
    float gv[16];
#pragma unroll
    for (int j = 0; j < 4; ++j) { const f32x4 g = *(const f32x4*)(A.in[25] + c0 + 4 * j); gv[4 * j] = g.x; gv[4 * j + 1] = g.y; gv[4 * j + 2] = g.z; gv[4 * j + 3] = g.w; }
    for (int rowA = gw; rowA < TL; rowA += 2 * NGW) {
        const bool vB = rowA + NGW < TL;
        const bf16* xa = F.X + (size_t)(F.grp * TL + rowA) * D + c0; const bf16* xb = F.X + (size_t)(F.grp * TL + (vB ? rowA + NGW : rowA)) * D + c0;
        const v4u a0 = *(const v4u*)xa, a1 = *(const v4u*)(xa + 8), b0 = *(const v4u*)xb, b1 = *(const v4u*)(xb + 8);
#pragma unroll
        for (int q = 0; q < 2; ++q) {
            if (q == 1 && !vB) break;
            const int row = F.grp * TL + rowA + q * NGW;
            float x[16]; unpk8(q == 0 ? a0 : b0, x); unpk8(q == 0 ? a1 : b1, x + 8);
            float s = 0.f;
#pragma unroll
            for (int i = 0; i < 16; ++i) s += x[i] * x[i];
            const float rinv = 1.0f / sqrtf(wave_sum(s) * (1.f / D) + EPS);
#pragma unroll
            for (int j = 0; j < 4; ++j) *(f32x4*)(A.out + (size_t)row * D + c0 + 4 * j) = (f32x4){x[4 * j] * rinv * gv[4 * j], x[4 * j + 1] * rinv * gv[4 * j + 1], x[4 * j + 2] * rinv * gv[4 * j + 2], x[4 * j + 3] * rinv * gv[4 * j + 3]};
        }
    }
}

struct EpiInproj {
    static constexpr bool PERM = true, AFTER_DRAIN = false;
    bf16* P; float* G;
    __device__ __forceinline__ void operator()(const f32x4 (&acc)[2][2][4][2], const pg8::Unit& u, int wr, int wc, int fr, int fq) const {
        const int row0 = u.pm * 256 + wr * 64 + fr;
        if (u.pn < 12) {
            const int col0 = u.pn * 256 + wc * 32 + 8 * fq;
#pragma unroll
            for (int ai = 0; ai < 2; ++ai)
#pragma unroll
                for (int m = 0; m < 4; ++m) { bf16* rowp = P + (size_t)(row0 + ai * 128 + m * 16) * PLD + col0;
#pragma unroll
                    for (int bj = 0; bj < 2; ++bj) { const f32x4 v0 = acc[ai][bj][m][0], v1 = acc[ai][bj][m][1];
                        const v4u w = cvt8_st(v0[0], v0[1], v0[2], v0[3], v1[0], v1[1], v1[2], v1[3]);
                        *(v4u*)(rowp + bj * 128) = w; } }
        } else if (wc == 0) {
#pragma unroll
            for (int ai = 0; ai < 2; ++ai)
#pragma unroll
                for (int m = 0; m < 4; ++m) { float* rowp = G + (size_t)(row0 + ai * 128 + m * 16) * 32 + 8 * fq;
                    *(f32x4*)(rowp) = acc[ai][0][m][0]; *(f32x4*)(rowp + 4) = acc[ai][0][m][1]; }
        }
    }
};
struct EpiResid {
    static constexpr bool PERM = false, AFTER_DRAIN = false;
    float* X; const float* gate;
    __device__ __forceinline__ void operator()(const f32x4 (&acc)[2][2][4][2], const pg8::Unit& u, int wr, int wc, int fr, int fq) const {
        const int row0 = u.pm * 256 + wr * 64 + fr, col0 = u.pn * 256 + wc * 32 + 4 * fq;
        const int r = u.pm < 64 ? (u.pm >> 3) : 8;
        const float* gp = gate + (size_t)r * 6144 + col0;
        f32x4 gv[2][2];
#pragma unroll
        for (int bj = 0; bj < 2; ++bj)
#pragma unroll
            for (int n = 0; n < 2; ++n) gv[bj][n] = *(const f32x4*)(gp + bj * 128 + n * 16);
#pragma unroll
        for (int ai = 0; ai < 2; ++ai)
#pragma unroll
            for (int m = 0; m < 4; ++m) { float* rowp = X + (size_t)(row0 + ai * 128 + m * 16) * D + col0;
#pragma unroll
                for (int bj = 0; bj < 2; ++bj)
#pragma unroll
                    for (int n = 0; n < 2; ++n) { float* p = rowp + bj * 128 + n * 16; *(f32x4*)p = *(const f32x4*)p + gv[bj][n] * acc[ai][bj][m][n]; } }
    }
};
struct GroupOrder {
    int g, mi, npan, nN, ntK, wid;
    __device__ bool next(int i, pg8::Unit& u) const {
        const int L = i * 32 + mi; if (L >= npan * nN) return false;
        const int pcol = L / npan, p = L - pcol * npan;
        u.pm = p < 8 ? g * 8 + p : 64 + g; u.pn = pcol; u.k0 = 0; u.nt = ntK; return true;
    }
    __device__ __forceinline__ void a_ready(const pg8::Unit&) const {}
    __device__ __forceinline__ void done(const pg8::Unit&) const {}
};
struct GroupSplitOrder {
    int g, mi, ntK, np, wid;
    __device__ bool next(int i, pg8::Unit& u) const {
        const bool piece = mi < np;
        if (piece && i == 0) { u.pm = 64 + g;
            if (ntK == 16) { const int q = mi & 3; u.pn = mi >> 2; u.k0 = q * 256; u.nt = 4; }
            else { const int q = mi & 7; u.pn = mi >> 3; u.k0 = (q < 6 ? 6 * q : 36 + 4 * (q - 6)) * 64; u.nt = q < 6 ? 6 : 4; }
            return true; }
        if (i == (piece ? 1 : 0)) { u.pm = g * 8 + (mi & 7); u.pn = mi >> 3; u.k0 = 0; u.nt = ntK; return true; }
        return false;
    }
    __device__ __forceinline__ void a_ready(const pg8::Unit&) const {}
    __device__ __forceinline__ void done(const pg8::Unit&) const {}
};
struct SplitOrder {
    pg8::StaticOrder lat; int G, c, ntK, np, wid;
    __device__ void init(int K, int G_, int c_, bool with_ctx) { lat.init(ML, D, G_, c_); lat.ntK = K / 64; G = G_; c = c_; ntK = K / 64; np = with_ctx ? 128 : 0; }
    __device__ bool next(int i, pg8::Unit& u) const {
        if (G == 256) {
            if (c < np) { if (i == 0) {   } else if (i == 1) return lat.next(0, u); else return false; }
            else return i == 0 ? lat.next(0, u) : false;
        }
        const int L = G == 256 ? 256 + c : i * G + c;
        if (L < 256) return lat.next(i, u);
        const int piece = L - 256; if (piece >= np) return false;
        const int unit = piece >> 2, q = piece & 3;
        u.pm = 64 + (unit >> 2); u.pn = unit & 3;
        if (ntK == 16) { u.k0 = q * 256; u.nt = 4; }
        else { u.k0 = (q < 2 ? q * 10 : 20 + (q - 2) * 12) * 64; u.nt = q < 2 ? 10 : 12; }
        return true;
    }
    __device__ __forceinline__ void a_ready(const pg8::Unit&) const {}
    __device__ __forceinline__ void done(const pg8::Unit&) const {}
};
struct EpiResidSplit {
    static constexpr bool PERM = true, AFTER_DRAIN = false;
    bf16* X; const float* gate; float* SLAB; int dry;
    __device__ __forceinline__ void operator()(const f32x4 (&acc)[2][2][4][2], const pg8::Unit& u, int wr, int wc, int fr, int fq) const {
        const int row0 = u.pm * 256 + wr * 64 + fr, col0 = u.pn * 256 + wc * 32 + 8 * fq;
        if (u.pm < 64) {
            if (dry) return;
            const float* gp = gate + (size_t)(u.pm >> 3) * 6144 + col0;
            f32x4 g0[2], g1[2];
#pragma unroll
            for (int bj = 0; bj < 2; ++bj) { g0[bj] = *(const f32x4*)(gp + bj * 128); g1[bj] = *(const f32x4*)(gp + bj * 128 + 4); }
#pragma unroll
            for (int ai = 0; ai < 2; ++ai)
#pragma unroll
                for (int m = 0; m < 4; ++m) { bf16* rowp = X + (size_t)(row0 + ai * 128 + m * 16) * D + col0;
#pragma unroll
                    for (int bj = 0; bj < 2; ++bj) { bf16* pp = rowp + bj * 128; const v4u xo = *(const v4u*)pp;
                        const f32x4 x0 = (f32x4){bflo(xo.x), bfhi(xo.x), bflo(xo.y), bfhi(xo.y)} + g0[bj] * acc[ai][bj][m][0];
                        const f32x4 x1 = (f32x4){bflo(xo.z), bfhi(xo.z), bflo(xo.w), bfhi(xo.w)} + g1[bj] * acc[ai][bj][m][1];
                        const v4u w = cvt8_st(x0[0], x0[1], x0[2], x0[3], x1[0], x1[1], x1[2], x1[3]);
                        *(v4u*)pp = w; } }
        } else {
            const int q = u.nt == 6 ? u.k0 / 384 : (u.k0 >= 2304 ? 6 + ((u.k0 - 2304) >> 8) : (u.k0 >> 8));
            bf16* sb = (bf16*)SLAB + (size_t)q * MC * D;
#pragma unroll
            for (int ai = 0; ai < 2; ++ai)
#pragma unroll
                for (int m = 0; m < 4; ++m) { bf16* rowp = sb + (size_t)(row0 - ML + ai * 128 + m * 16) * D + col0;
#pragma unroll
                    for (int bj = 0; bj < 2; ++bj) { const f32x4 v0 = acc[ai][bj][m][0], v1 = acc[ai][bj][m][1];
                        const v4u w = cvt8_st(v0[0], v0[1], v0[2], v0[3], v1[0], v1[1], v1[2], v1[3]);
                        *(v4u*)(rowp + bj * 128) = w; } }
        }
    }
};
struct EpiConvGate {
    static constexpr bool PERM = false, AFTER_DRAIN = false;
    bf16* ACT; float* EDGE; const float* cw; const float* cb; LAS float* ce;
    __device__ __forceinline__ void operator()(const f32x4 (&acc)[2][2][4][2], const pg8::Unit& u, int wr, int wc, int fr, int fq) const {
        const int lane = fq * 16 + fr;
        float pw[2][8];
#pragma unroll
        for (int n = 0; n < 2; ++n) { const int c = u.pn * 128 + wc * 32 + n * 16 + fr;
            pw[n][0] = cw[c]; pw[n][1] = cw[FF2 + c]; pw[n][2] = cw[2 * FF2 + c]; pw[n][3] = cb[c];
            pw[n][4] = cw[FF + c]; pw[n][5] = cw[FF2 + FF + c]; pw[n][6] = cw[2 * FF2 + FF + c]; pw[n][7] = cb[FF + c]; }
#pragma unroll
        for (int ai = 0; ai < 2; ++ai) { const int blk = ai * 2 + wr;
#pragma unroll
            for (int bj = 0; bj < 2; ++bj)
#pragma unroll
                for (int n = 0; n < 2; ++n) { const int col = bj * 128 + wc * 32 + n * 16 + fr;
                    if (fq == 0) ce[(blk * 2 + 0) * 256 + col] = acc[ai][bj][0][n][0];
                    if (fq == 3) ce[(blk * 2 + 1) * 256 + col] = acc[ai][bj][3][n][3]; } }
        {
            float* eb = EDGE + (size_t)u.pm * 4 * FF2 + u.pn * 256;
#pragma unroll
            for (int bj = 0; bj < 2; ++bj)
#pragma unroll
                for (int n = 0; n < 2; ++n) { const int col = bj * 128 + wc * 32 + n * 16 + fr;
                    if (wr == 0 && fq == 0) { eb[0 * FF2 + col] = acc[0][bj][0][n][0]; eb[1 * FF2 + col] = acc[0][bj][0][n][1]; }
                    if (wr == 1 && fq == 3) { eb[2 * FF2 + col] = acc[1][bj][3][n][2]; eb[3 * FF2 + col] = acc[1][bj][3][n][3]; } }
        }
        asm volatile("s_waitcnt lgkmcnt(0)" ::: "memory"); __builtin_amdgcn_s_barrier(); asm volatile("" ::: "memory");
        const int upl = (lane + 48) & 63, dnl = (lane + 16) & 63;
        bf16* tb = ACT + (size_t)u.pm * 256 * FF + u.pn * 128;
        bf16* tb1 = tb + FF; bf16* tb2 = tb + 2 * FF; bf16* tb3 = tb + 3 * FF;
#pragma unroll
        for (int n = 0; n < 2; ++n) {
            const int c = u.pn * 128 + wc * 32 + n * 16 + fr;
            const float kg = -1.4426950408889634f, ka = -0.6931471805599453f;
            const float wa0 = pw[n][0] * ka, wa1 = pw[n][1] * ka, wa2 = pw[n][2] * ka, ba = pw[n][3] * ka;
            const float wg0 = pw[n][4] * kg, wg1 = pw[n][5] * kg, wg2 = pw[n][6] * kg, bg = pw[n][7] * kg;
#pragma unroll
            for (int ai = 0; ai < 2; ++ai) {
                const int blk = ai * 2 + wr;
                const int cola = wc * 32 + n * 16 + fr, colg = 128 + cola;
                const float epa = blk > 0 ? ce[((blk - 1) * 2 + 1) * 256 + cola] : 0.f, epg = blk > 0 ? ce[((blk - 1) * 2 + 1) * 256 + colg] : 0.f;
                const float ena = blk < 3 ? ce[((blk + 1) * 2 + 0) * 256 + cola] : 0.f, eng = blk < 3 ? ce[((blk + 1) * 2 + 0) * 256 + colg] : 0.f;
                float sUa[4], sDa[4], sUg[4], sDg[4];
#pragma unroll
                for (int m = 0; m < 4; ++m) { sUa[m] = __shfl(acc[ai][0][m][n][3], upl); sDa[m] = __shfl(acc[ai][0][m][n][0], dnl);
                                              sUg[m] = __shfl(acc[ai][1][m][n][3], upl); sDg[m] = __shfl(acc[ai][1][m][n][0], dnl); }
#pragma unroll
                for (int m = 0; m < 4; ++m) {
                    const f32x4 xa = acc[ai][0][m][n], xg = acc[ai][1][m][n];
                    const float pa = fq > 0 ? sUa[m] : (m > 0 ? sUa[m > 0 ? m - 1 : 0] : epa), pg = fq > 0 ? sUg[m] : (m > 0 ? sUg[m > 0 ? m - 1 : 0] : epg);
                    const float na = fq < 3 ? sDa[m] : (m < 3 ? sDa[m < 3 ? m + 1 : 3] : ena), ng = fq < 3 ? sDg[m] : (m < 3 ? sDg[m < 3 ? m + 1 : 3] : eng);
                    const float a0 = fmaf(wa0, pa,    fmaf(wa1, xa[0], fmaf(wa2, xa[1], ba))), g0 = fmaf(wg0, pg,    fmaf(wg1, xg[0], fmaf(wg2, xg[1], bg)));
                    const float a1 = fmaf(wa0, xa[0], fmaf(wa1, xa[1], fmaf(wa2, xa[2], ba))), g1 = fmaf(wg0, xg[0], fmaf(wg1, xg[1], fmaf(wg2, xg[2], bg)));
                    const float a2 = fmaf(wa0, xa[1], fmaf(wa1, xa[2], fmaf(wa2, xa[3], ba))), g2 = fmaf(wg0, xg[1], fmaf(wg1, xg[2], fmaf(wg2, xg[3], bg)));
                    const float a3 = fmaf(wa0, xa[2], fmaf(wa1, xa[3], fmaf(wa2, na,    ba))), g3 = fmaf(wg0, xg[2], fmaf(wg1, xg[3], fmaf(wg2, ng,    bg)));
                    const float y0 = (a0 * g0) * __builtin_amdgcn_rcpf(1.0f + __builtin_amdgcn_exp2f(g0)), y1 = (a1 * g1) * __builtin_amdgcn_rcpf(1.0f + __builtin_amdgcn_exp2f(g1));
                    const float y2 = (a2 * g2) * __builtin_amdgcn_rcpf(1.0f + __builtin_amdgcn_exp2f(g2)), y3 = (a3 * g3) * __builtin_amdgcn_rcpf(1.0f + __builtin_amdgcn_exp2f(g3));
                    const unsigned ob = ((unsigned)(ai * 128 + wr * 64 + m * 16 + 4 * fq) * FF + (unsigned)(wc * 32 + n * 16 + fr)) * 2u;
                    const unsigned p01 = cvtpk(y0, y1), p23 = cvtpk(y2, y3);
                    asm volatile("global_store_short %0, %1, %2" :: "v"(ob), "v"(p01), "s"(tb) : "memory");
                    asm volatile("global_store_short_d16_hi %0, %1, %2" :: "v"(ob), "v"(p01), "s"(tb1) : "memory");
                    asm volatile("global_store_short %0, %1, %2" :: "v"(ob), "v"(p23), "s"(tb2) : "memory");
                    asm volatile("global_store_short_d16_hi %0, %1, %2" :: "v"(ob), "v"(p23), "s"(tb3) : "memory");
                }
            }
        }
        asm volatile("s_waitcnt lgkmcnt(0)" ::: "memory"); __builtin_amdgcn_s_barrier(); asm volatile("" ::: "memory");
    }
};
__device__ __forceinline__ void ffn_fixup_phase(Frame& F, const Args& A, int layer) {
    bf16* ACT = F.P16;
    const float* cw = A.in[9] + (size_t)layer * 3 * FF2; const float* cb = A.in[10] + (size_t)layer * FF2;
    for (int task = 14 * F.grp + F.mi; task < 14 * F.grp + 14; task += 32) {
        const int bnd = task >> 1, lower = task & 1;
        const int pmA = (bnd / 7) * 8 + (bnd % 7);
        const float* eA = F.EDGE + (size_t)pmA * 4 * FF2; const float* eB = eA + 4 * FF2;
        const float* rp = lower ? eA + 3 * FF2 : eA + 2 * FF2;
        const float* rc = lower ? eB + 0 * FF2 : eA + 3 * FF2;
        const float* rn = lower ? eB + 1 * FF2 : eB + 0 * FF2;
        const int row = lower ? (pmA + 1) * 256 : pmA * 256 + 255;
        for (int c = F.tid; c < FF; c += NTHR) {
            const int ea = (c >> 7) * 256 + (c & 127), eg = ea + 128;
            const float a = cw[c] * rp[ea] + cw[FF2 + c] * rc[ea] + cw[2 * FF2 + c] * rn[ea] + cb[c];
            const float g = cw[FF + c] * rp[eg] + cw[FF2 + FF + c] * rc[eg] + cw[2 * FF2 + FF + c] * rn[eg] + cb[FF + c];
            ACT[(size_t)row * FF + c] = (bf16)f2bf(a * siluf_(g));
        }
    }
}

#define MFMA16(a, b, c) __builtin_amdgcn_mfma_f32_16x16x32_bf16((a), (b), (c), 0, 0, 0)
__device__ __forceinline__ bf16x8 cvt8_mma(float a0, float a1, float a2, float a3, float a4, float a5, float a6, float a7) {
    v4u p;
    asm volatile("s_nop 0\n\tv_cvt_pk_bf16_f32 %0, %4, %5\n\tv_cvt_pk_bf16_f32 %1, %6, %7\n\tv_cvt_pk_bf16_f32 %2, %8, %9\n\tv_cvt_pk_bf16_f32 %3, %10, %11\n\ts_nop 1"
                 : "=&v"(p.x), "=&v"(p.y), "=&v"(p.z), "=&v"(p.w) : "v"(a0), "v"(a1), "v"(a2), "v"(a3), "v"(a4), "v"(a5), "v"(a6), "v"(a7));
    return __builtin_bit_cast(bf16x8, p);
}
#define PIN2(a, b) asm volatile("" : "+v"(a), "+v"(b))
#define PIN4(a, b, c, d) asm volatile("" : "+v"(a), "+v"(b), "+v"(c), "+v"(d))
#define PIN5(a, b, c, d, e) asm volatile("" : "+v"(a), "+v"(b), "+v"(c), "+v"(d), "+v"(e))
#define PIN8(a, b, c, d, e, f, g, h) asm volatile("" : "+v"(a), "+v"(b), "+v"(c), "+v"(d), "+v"(e), "+v"(f), "+v"(g), "+v"(h))
__device__ __forceinline__ bf16x8 ldfrag(const LAS bf16* base, int ld, int r0, int k0, int lane) {
    return *(const LAS bf16x8*)(base + (r0 + (lane & 15)) * ld + k0 + 8 * (lane >> 4));
}
__device__ __forceinline__ void unpack8(const v4u w, float* f) {
    f[0] = bflo(w.x); f[1] = bfhi(w.x); f[2] = bflo(w.y); f[3] = bfhi(w.y); f[4] = bflo(w.z); f[5] = bfhi(w.z); f[6] = bflo(w.w); f[7] = bfhi(w.w);
}
__device__ __forceinline__ v4u pack8(const float* f) { v4u w; w.x = pk2(f[0], f[1]); w.y = pk2(f[2], f[3]); w.z = pk2(f[4], f[5]); w.w = pk2(f[6], f[7]); return w; }

typedef short s16x4 __attribute__((ext_vector_type(4)));
__device__ __forceinline__ bf16x8 ldfrag_tr(const LAS bf16* base, int ld, int k0, int c0, int lane) {
    const int i = lane & 15, kq = lane >> 4;
    const LAS bf16* p = base + (k0 + 8 * kq + (i >> 2)) * ld + c0 + 4 * (i & 3);
    const s16x4 lo = __builtin_amdgcn_ds_read_tr16_b64_v4i16((LAS s16x4*)p);
    const s16x4 hi = __builtin_amdgcn_ds_read_tr16_b64_v4i16((LAS s16x4*)(p + 4 * ld));
    return (bf16x8){lo.x, lo.y, lo.z, lo.w, hi.x, hi.y, hi.z, hi.w};
}
__device__ __forceinline__ bf16x8 ldfrag_tr4(const LAS bf16* base, int ld, int s0, int c0, int lane) {
    const int i = lane & 15, kq = lane >> 4;
    const LAS bf16* p = base + (s0 + 4 * kq + (i >> 2)) * ld + c0 + 4 * (i & 3);
    const s16x4 lo = __builtin_amdgcn_ds_read_tr16_b64_v4i16((LAS s16x4*)p);
    const s16x4 hi = __builtin_amdgcn_ds_read_tr16_b64_v4i16((LAS s16x4*)(p + 16 * ld));
    return (bf16x8){lo.x, lo.y, lo.z, lo.w, hi.x, hi.y, hi.z, hi.w};
}
__device__ __forceinline__ void mlstm_prep_phase(Frame& F, const Args& A, int jk, bf16* QKl, bf16* QKc) {
    const float* convw = A.in[14] + (size_t)jk * 3 * 1024; const float* convb = A.in[15] + (size_t)jk * 1024;
    const int gw = F.mi * NWAVES + F.wave, NGW = 32 * NWAVES, lane = F.lane;
    for (int task = gw; task < 576; task += NGW) {
        const int half = task & 1, row0 = grow(F, (task >> 1) * 8);
        const bool lat = row0 < ML;
        const int tpos = lat ? (row0 & (TL - 1)) : ((row0 - ML) & (TC - 1)), Tn = lat ? TL : TC;
        const int c0 = half * 512 + lane * 8;
        float w0[8], w1[8], w2[8], bb[8];
#pragma unroll
        for (int i = 0; i < 8; ++i) { w0[i] = convw[c0 + i]; w1[i] = convw[1024 + c0 + i]; w2[i] = convw[2048 + c0 + i]; bb[i] = convb[c0 + i]; }
        const float sc = half == 0 ? 0.125f : 1.0f;
        const bf16* src = F.P16 + (size_t)row0 * PLD + c0;
        bf16* dst = (lat ? QKl + (size_t)row0 * D : QKc + (size_t)(row0 - ML) * D) + c0;
        v4u xr[10];
#pragma unroll
        for (int i = 0; i < 10; ++i) { const int tp = tpos - 1 + i; xr[i] = (tp >= 0 && tp < Tn) ? *(const v4u*)(src + (ptrdiff_t)(i - 1) * PLD) : (v4u){0u, 0u, 0u, 0u}; }
#pragma unroll
        for (int t = 0; t < 8; ++t) {
            float xp[8], xc[8], xn[8], y[8];
            unpack8(xr[t], xp); unpack8(xr[t + 1], xc); unpack8(xr[t + 2], xn);
#pragma unroll
            for (int i = 0; i < 8; ++i) y[i] = siluf_(w0[i] * xp[i] + w1[i] * xc[i] + w2[i] * xn[i] + bb[i]) * sc;
            *(v4u*)(dst + (size_t)t * D) = pack8(y);
        }
    }
}
__device__ __forceinline__ void mlstm_phase(Frame& F, const Args& A, int jk, const bf16* QKl, const bf16* QKc, f32x4* GJ) {
    LAS float* ga = (LAS float*)(F.lds + 57344);
    LAS float* aa = (LAS float*)(F.lds + 57344 + 9216);
    LAS float* cma = (LAS float*)(F.lds + 57344 + 18432);
    LAS float* scl = (LAS float*)(F.lds + 137728);
    const float* bgate = A.in[13] + jk * 32;
    const int tid = F.tid, lane = F.lane, wave = F.wave, fr = lane & 15, fq = lane >> 4;
    for (int task = F.vcu; task < 256; task += F.G) {
        const int eh = task & 1, dir = (task >> 1) & 1, h = (task >> 2) & 7, b = task >> 5;
        const int e0 = eh * 64;
        bf16* Hout = dir == 0 ? F.H16 : F.HB16;
        f32x4* gj = GJ + (size_t)task * 2304;
        __syncthreads();
        for (int i = tid; i < 80 * 72 / 2; i += NTHR) ((LAS unsigned*)(F.lds + 114688))[i] = 0u;
        if (tid < 256) { unsigned z_ = 0u; asm volatile("" : "+v"(z_));
            LAS v4u* p = (LAS v4u*)(F.lds + (tid >> 7) * 57344 + 36864 + ((tid & 127) * 80 + 64) * 2); p[0] = (v4u){0x3F80u | z_, z_, z_, z_}; p[1] = (v4u){z_, z_, z_, z_}; }
        {
            const float bi = bgate[(2 * dir) * 8 + h], bfg = bgate[(2 * dir + 1) * 8 + h];
            for (int c = wave; c < 18; c += 8) {
                const bool isctx = c < 2; const int cc = isctx ? c : c - 2; const int Tn = isctx ? TC : TL;
                const int rowbase = isctx ? ML + b * TC : b * TL;
                const int t0 = dir == 0 ? cc * 128 : Tn - 128 * (cc + 1);
                const int j0 = 2 * lane, p0 = dir == 0 ? t0 + j0 : t0 + 127 - j0, p1 = dir == 0 ? p0 + 1 : p0 - 1;
                const float* g0p = F.G32 + (size_t)(rowbase + p0) * 32; const float* g1p = F.G32 + (size_t)(rowbase + p1) * 32;
                const float ig0 = g0p[(2 * dir) * 8 + h] + bi, lf0 = logsigmoidf_(g0p[(2 * dir + 1) * 8 + h] + bfg);
                const float ig1 = g1p[(2 * dir) * 8 + h] + bi, lf1 = logsigmoidf_(g1p[(2 * dir + 1) * 8 + h] + bfg);
                float sum = lf0 + lf1;
#pragma unroll
                for (int o = 1; o < 64; o <<= 1) { const float t = __shfl_up(sum, o); if (lane >= o) sum += t; }
                const float gg0 = sum - lf1, gg1 = sum;
                const float a0 = ig0 - gg0, a1 = ig1 - gg1;
                float mx = fmaxf(a0, a1);
#pragma unroll
                for (int o = 1; o < 64; o <<= 1) { const float t = __shfl_up(mx, o); if (lane >= o) mx = fmaxf(mx, t); }
                float ex = __shfl_up(mx, 1); if (lane == 0) ex = -INFINITY;
                const float c0v = fmaxf(ex, a0), c1v = mx;
                ga[c * 128 + j0] = gg0; ga[c * 128 + j0 + 1] = gg1; aa[c * 128 + j0] = a0; aa[c * 128 + j0 + 1] = a1; cma[c * 128 + j0] = c0v; cma[c * 128 + j0 + 1] = c1v;
                if (lane == 63) { scl[c] = gg1; scl[32 + c] = c1v; }
            }
        }
        __syncthreads();
        if (tid == 0) { float m = 0.f;
            for (int c = 0; c < 18; ++c) { const float gL = scl[c], cmL = scl[32 + c], mn = gL + fmaxf(m, cmL); scl[64 + c] = m; scl[96 + c] = __expf(gL + m - mn); scl[128 + c] = __expf(gL + cmL - mn); m = mn; } }
        __syncthreads();
        for (int idx = tid; idx < 2304; idx += NTHR) { const int c = idx >> 7; const float mc = scl[64 + c], cmL = scl[32 + c], mxj = fmaxf(cma[idx], mc);
            gj[idx] = (f32x4){__expf(aa[idx] - cmL), __expf(cmL - mxj), __expf(mc - mxj), __expf(-(ga[idx] + mxj))}; }
        asm volatile("s_waitcnt vmcnt(0)" ::: "memory");
        __syncthreads();
        f32x4 st[5];
#pragma unroll
        for (int k = 0; k < 5; ++k) st[k] = (f32x4){0.f, 0.f, 0.f, 0.f};
        const int nst = wave < 2 ? 5 : (wave < 4 ? 3 : (wave < 6 ? 2 : 0));
        const int st0i = wave < 2 ? wave * 5 : (wave < 4 ? 10 + (wave - 2) * 3 : 16 + (wave - 4) * 2);
        const int s = tid >> 2, cg = tid & 3, jt = wave;
        v4u rq0, rq1, rk0, rk1, rv0, rv1; float e1n; f32x4 jn;
#define MLSTM_LOAD(stepn) do { const bool ic_ = (stepn) < 2; const int c_ = ic_ ? (stepn) : (stepn) - 2, Tn_ = ic_ ? TC : TL; \
            const int t0_ = dir == 0 ? c_ * 128 : Tn_ - 128 * (c_ + 1), pos_ = dir == 0 ? t0_ + s : t0_ + 127 - s; \
            const bf16* qk_ = ic_ ? QKc + (size_t)(b * TC + pos_) * D : QKl + (size_t)(b * TL + pos_) * D; \
            const bf16* pv_ = F.P16 + (size_t)((ic_ ? ML + b * TC : b * TL) + pos_) * PLD + 1024 + h * 128 + e0 + cg * 16; \
            rq0 = *(const v4u*)(qk_ + h * 64 + cg * 16); rq1 = *(const v4u*)(qk_ + h * 64 + cg * 16 + 8); \
            rk0 = *(const v4u*)(qk_ + 512 + h * 64 + cg * 16); rk1 = *(const v4u*)(qk_ + 512 + h * 64 + cg * 16 + 8); \
            rv0 = *(const v4u*)(pv_); rv1 = *(const v4u*)(pv_ + 8); \
            e1n = ((const float*)(gj + (stepn) * 128 + s))[0]; jn = gj[(stepn) * 128 + 16 * jt + fr]; } while (0)
        MLSTM_LOAD(0);
        for (int step = 0; step < 18; ++step) {
            const int p = step & 1;
            LAS bf16* Qs = (LAS bf16*)(F.lds + p * 57344);
            LAS bf16* Kw = (LAS bf16*)(F.lds + p * 57344 + 18432);
            LAS bf16* Vs = (LAS bf16*)(F.lds + p * 57344 + 36864);
            const LAS bf16* CTr = (const LAS bf16*)(F.lds + 114688 + p * 11520);
            LAS bf16* CTw = (LAS bf16*)(F.lds + 114688 + (p ^ 1) * 11520);
            const bool isctx = step < 2; const int c = isctx ? step : step - 2; const int Tn = isctx ? TC : TL;
            const int rowbase = isctx ? ML + b * TC : b * TL;
            const int t0 = dir == 0 ? c * 128 : Tn - 128 * (c + 1);
            {
                *(LAS v4u*)(Qs + s * 72 + cg * 16) = rq0; *(LAS v4u*)(Qs + s * 72 + cg * 16 + 8) = rq1;
                float kf[16]; unpack8(rk0, kf); unpack8(rk1, kf + 8);
#pragma unroll
                for (int i = 0; i < 16; ++i) kf[i] *= e1n;
                v4u w0, w1; w0.x = pg8::cvt_pk_bf16(kf[0], kf[1]); w0.y = pg8::cvt_pk_bf16(kf[2], kf[3]); w0.z = pg8::cvt_pk_bf16(kf[4], kf[5]); w0.w = pg8::cvt_pk_bf16(kf[6], kf[7]);
                w1.x = pg8::cvt_pk_bf16(kf[8], kf[9]); w1.y = pg8::cvt_pk_bf16(kf[10], kf[11]); w1.z = pg8::cvt_pk_bf16(kf[12], kf[13]); w1.w = pg8::cvt_pk_bf16(kf[14], kf[15]);
                *(LAS v4u*)(Kw + s * 72 + cg * 16) = w0; *(LAS v4u*)(Kw + s * 72 + cg * 16 + 8) = w1;
                *(LAS v4u*)(Vs + s * 80 + cg * 16) = rv0; *(LAS v4u*)(Vs + s * 80 + cg * 16 + 8) = rv1;
            }
            const float e2 = jn.y, itr = jn.z, enm = jn.w;
            if (step + 1 < 18) MLSTM_LOAD(step + 1);
            asm volatile("s_waitcnt lgkmcnt(0)" ::: "memory"); __builtin_amdgcn_s_barrier(); asm volatile("" ::: "memory");
            {
                bf16x8 qb0 = ldfrag(Qs, 72, 16 * jt, 0, lane), qb1 = ldfrag(Qs, 72, 16 * jt, 32, lane);
                f32x4 nT[5];
#pragma unroll
                for (int et = 0; et < 5; ++et) nT[et] = (f32x4){0.f, 0.f, 0.f, 0.f};
                for (int sp = 0; sp <= (jt >> 1); ++sp) {
                    const int ts0 = 2 * sp, ts1 = 2 * sp + 1;
                    bf16x8 k0a = ldfrag(Kw, 72, 16 * ts0, 0, lane), k0b = ldfrag(Kw, 72, 16 * ts0, 32, lane), k1a = ldfrag(Kw, 72, 16 * ts1, 0, lane), k1b = ldfrag(Kw, 72, 16 * ts1, 32, lane);
                    bf16x8 vf[5];
#pragma unroll
                    for (int et = 0; et < 5; ++et) vf[et] = ldfrag_tr4(Vs, 80, 32 * sp, 16 * et, lane);
                    PIN2(qb0, qb1); PIN4(k0a, k0b, k1a, k1b); PIN5(vf[0], vf[1], vf[2], vf[3], vf[4]);
                    f32x4 sT0 = {0.f, 0.f, 0.f, 0.f}, sT1 = sT0, sT2 = sT0, sT3 = sT0;
                    sT0 = MFMA16(k0a, qb0, sT0); sT1 = MFMA16(k1a, qb0, sT1); sT2 = MFMA16(k0b, qb1, sT2); sT3 = MFMA16(k1b, qb1, sT3);
                    sT0 = sT0 + sT2; sT1 = sT1 + sT3;
#pragma unroll
                    for (int reg = 0; reg < 4; ++reg) { const bool v0 = (ts0 < jt) || (4 * fq + reg <= fr), v1 = (ts1 < jt) || (ts1 == jt && 4 * fq + reg <= fr);
                        sT0[reg] = v0 ? sT0[reg] : 0.f; sT1[reg] = v1 ? sT1[reg] : 0.f; }
                    const bf16x8 pf = cvt8_mma(sT0[0], sT0[1], sT0[2], sT0[3], sT1[0], sT1[1], sT1[2], sT1[3]);
#pragma unroll
                    for (int et = 0; et < 5; ++et) nT[et] = MFMA16(vf[et], pf, nT[et]);
                }
                {
                    bf16x8 cf[10];
#pragma unroll
                    for (int et = 0; et < 5; ++et) { cf[2 * et] = ldfrag(CTr, 72, 16 * et, 0, lane); cf[2 * et + 1] = ldfrag(CTr, 72, 16 * et, 32, lane); }
                    PIN5(cf[0], cf[1], cf[2], cf[3], cf[4]); PIN5(cf[5], cf[6], cf[7], cf[8], cf[9]);
                    f32x4 qc[5], qd[5];
#pragma unroll
                    for (int et = 0; et < 5; ++et) { qc[et] = (f32x4){0.f, 0.f, 0.f, 0.f}; qc[et] = MFMA16(cf[2 * et], qb0, qc[et]); }
#pragma unroll
                    for (int et = 0; et < 5; ++et) { qd[et] = (f32x4){0.f, 0.f, 0.f, 0.f}; qd[et] = MFMA16(cf[2 * et + 1], qb1, qd[et]); }
#pragma unroll
                    for (int et = 0; et < 5; ++et) nT[et] = nT[et] * e2 + (qc[et] + qd[et]) * itr;
                }
                const float den = __shfl(nT[4][0], fr);
                const float inv = 1.0f / fmaxf(fabsf(den), enm);
                const int jj = 16 * jt + fr; const int pos = dir == 0 ? t0 + jj : t0 + 127 - jj;
                bf16* op = Hout + (size_t)(rowbase + pos) * D + h * 128 + e0 + 4 * fq;
#pragma unroll
                for (int et = 0; et < 4; ++et) { v2u w; w.x = pg8::cvt_pk_bf16(nT[et][0] * inv, nT[et][1] * inv); w.y = pg8::cvt_pk_bf16(nT[et][2] * inv, nT[et][3] * inv); *(v2u*)(op + 16 * et) = w; }
            }
            {
                const float decay = scl[96 + step], sc2 = scl[128 + step];
#pragma unroll
                for (int k = 0; k < 5; ++k) {
                    if (k < nst) { const int ti = st0i + k, et = ti >> 2, dt = ti & 3;
                        bf16x8 va[4], kb[4];
#pragma unroll
                        for (int ks = 0; ks < 4; ++ks) { va[ks] = ldfrag_tr(Vs, 80, 32 * ks, 16 * et, lane); kb[ks] = ldfrag_tr(Kw, 72, 32 * ks, 16 * dt, lane); }
                        PIN4(va[0], va[1], va[2], va[3]); PIN4(kb[0], kb[1], kb[2], kb[3]);
                        f32x4 t0a = {0.f, 0.f, 0.f, 0.f}, t1a = t0a;
                        t0a = MFMA16(va[0], kb[0], t0a); t1a = MFMA16(va[1], kb[1], t1a); t0a = MFMA16(va[2], kb[2], t0a); t1a = MFMA16(va[3], kb[3], t1a);
                        st[k] = st[k] * decay + (t0a + t1a) * sc2; }
                }
#pragma unroll
                for (int k = 0; k < 5; ++k) {
                    if (k < nst) { const int ti = st0i + k, et = ti >> 2, dt = ti & 3;
#pragma unroll
                        for (int reg = 0; reg < 4; ++reg) CTw[(16 * et + 4 * fq + reg) * 72 + 16 * dt + fr] = (bf16)f2bf(st[k][reg]); }
                }
            }
        }
#undef MLSTM_LOAD
    }
}
__device__ __forceinline__ void mlstm_combine_phase(Frame& F, const Args& A, int nrows) {
    const int gw = F.mi * NWAVES + F.wave, NGW = 32 * NWAVES, nloc = nrows == MT ? TL + TC : TL;
    for (int lr = gw; lr < nloc; lr += NGW) { const int row = grow(F, lr);
        bf16* hf = F.H16 + (size_t)row * D + F.lane * 16; const bf16* hb = F.HB16 + (size_t)row * D + F.lane * 16; const bf16* o = F.P16 + (size_t)row * PLD + 2048 + F.lane * 16;
#pragma unroll
        for (int hv = 0; hv < 2; ++hv) { float a[8], b2[8], g[8], y[8];
            unpack8(*(const v4u*)(hf + hv * 8), a); unpack8(*(const v4u*)(hb + hv * 8), b2); unpack8(*(const v4u*)(o + hv * 8), g);
#pragma unroll
            for (int i = 0; i < 8; ++i) y[i] = (a[i] + b2[i]) * sigmoidf_(g[i]);
            *(v4u*)(hf + hv * 8) = pack8(y); }
    }
}

__device__ __forceinline__ void gla_prep_phase(Frame& F, const Args& A, bf16* QGl, bf16* QGc, float* EGL) {
    const int gw = F.mi * NWAVES + F.wave, NGW = 32 * NWAVES, lane = F.lane;
    const float qscale = 0.08838834764831845f;
    LAS float* av = (LAS float*)(F.lds + F.wave * 4096);
    for (int task = gw; task < 144; task += NGW) {
        const int cgp = task & 1, dir = (task >> 1) & 1, lb = task >> 2, blk = lb < 32 ? F.grp * 32 + lb : 256 + F.grp * 4 + (lb - 32);
        const bool lat = blk < 256;
        const int rowbase = lat ? (blk >> 5) * TL + (blk & 31) * 64 : ML + ((blk - 256) >> 2) * TC + ((blk - 256) & 3) * 64;
        const int c4 = cgp * 256 + lane * 4;
        { const float* ap = F.G32 + (size_t)(rowbase + (dir == 0 ? lane : 63 - lane)) * 32 + dir * 16;
#pragma unroll
          for (int r4 = 0; r4 < 4; ++r4) *(LAS f32x4*)(av + lane * 16 + r4 * 4) = *(const f32x4*)(ap + r4 * 4); }
        float w2r[16][4], bzv[4], run[4];
#pragma unroll
        for (int r = 0; r < 16; ++r) { const f32x4 w = *(const f32x4*)(A.in[18] + (size_t)(dir * 16 + r) * 512 + c4); w2r[r][0] = w.x; w2r[r][1] = w.y; w2r[r][2] = w.z; w2r[r][3] = w.w; }
        { const f32x4 w = *(const f32x4*)(A.in[19] + dir * 512 + c4); bzv[0] = w.x; bzv[1] = w.y; bzv[2] = w.z; bzv[3] = w.w; }
#pragma unroll
        for (int i = 0; i < 4; ++i) run[i] = 0.f;
        v2u qn[4], kn[4];
#pragma unroll
        for (int t = 0; t < 4; ++t) { const int row = rowbase + (dir == 0 ? t : 63 - t); qn[t] = *(const v2u*)(F.P16 + (size_t)row * PLD + c4); kn[t] = *(const v2u*)(F.P16 + (size_t)row * PLD + 512 + c4); }
        for (int jb = 0; jb < 16; ++jb) {
            v2u qc_[4], kc_[4];
#pragma unroll
            for (int t = 0; t < 4; ++t) { qc_[t] = qn[t]; kc_[t] = kn[t]; }
            if (jb < 15) {
#pragma unroll
                for (int t = 0; t < 4; ++t) { const int jj = (jb + 1) * 4 + t; const int row = rowbase + (dir == 0 ? jj : 63 - jj); qn[t] = *(const v2u*)(F.P16 + (size_t)row * PLD + c4); kn[t] = *(const v2u*)(F.P16 + (size_t)row * PLD + 512 + c4); } }
#pragma unroll
            for (int t = 0; t < 4; ++t) {
                const int jj = jb * 4 + t; const int row = rowbase + (dir == 0 ? jj : 63 - jj);
                float z[4] = {bzv[0], bzv[1], bzv[2], bzv[3]};
#pragma unroll
                for (int r4 = 0; r4 < 4; ++r4) { const f32x4 a4 = *(const LAS f32x4*)(av + jj * 16 + r4 * 4);
#pragma unroll
                    for (int i = 0; i < 4; ++i) z[i] += a4.x * w2r[r4 * 4][i] + a4.y * w2r[r4 * 4 + 1][i] + a4.z * w2r[r4 * 4 + 2][i] + a4.w * w2r[r4 * 4 + 3][i]; }
                const float qf[4] = {bflo(qc_[t].x), bfhi(qc_[t].x), bflo(qc_[t].y), bfhi(qc_[t].y)}, kf[4] = {bflo(kc_[t].x), bfhi(kc_[t].x), bflo(kc_[t].y), bfhi(kc_[t].y)};
                float oq[4], ok[4];
#pragma unroll
                for (int i = 0; i < 4; ++i) { run[i] += (fminf(z[i], 0.f) - __logf(1.0f + __expf(-fabsf(z[i])))) * 0.0625f; const float eg = __expf(run[i]); oq[i] = qf[i] * qscale * eg; ok[i] = kf[i] * __builtin_amdgcn_rcpf(eg); }
                bf16* dst = (lat ? QGl + (size_t)row * 2048 : QGc + (size_t)(row - ML) * 2048) + dir * 1024 + c4;
                v2u o1; o1.x = pk2(oq[0], oq[1]); o1.y = pk2(oq[2], oq[3]); *(v2u*)dst = o1;
                v2u o2; o2.x = pk2(ok[0], ok[1]); o2.y = pk2(ok[2], ok[3]); *(v2u*)(dst + 512) = o2;
            }
        }
        *(f32x4*)(EGL + (size_t)blk * 1024 + dir * 512 + c4) = (f32x4){__expf(run[0]), __expf(run[1]), __expf(run[2]), __expf(run[3])};
    }
}
__device__ __forceinline__ void gla_phase(Frame& F, const Args& A, const bf16* QGl, const bf16* QGc, const float* EGL) {
    const int tid = F.tid, lane = F.lane, wave = F.wave, fr = lane & 15, fq = lane >> 4;
    for (int task = F.vcu; task < 256; task += F.G) {
        const int eq = task & 3, dir = (task >> 2) & 1, h = (task >> 3) & 3, b = task >> 5;
        const int e0 = eq * 64;
        bf16* Oout = dir == 0 ? F.H16 : F.HB16;
        __syncthreads();
        for (int i = tid; i < 64 * 136 / 2; i += NTHR) ((LAS unsigned*)(F.lds + 88064))[i] = 0u;
        f32x4 st[4];
#pragma unroll
        for (int k = 0; k < 4; ++k) st[k] = (f32x4){0.f, 0.f, 0.f, 0.f};
        const int s = tid >> 3, cg = tid & 7;
        v4u rq0, rq1, rk0, rk1, rv0, rv1; float egn[4], egc[4];
#define GLA_LOAD(stepn) do { const bool ic_ = (stepn) < 4; const int c_ = ic_ ? (stepn) : (stepn) - 4, Tn_ = ic_ ? TC : TL; \
            const int t0_ = dir == 0 ? c_ * 64 : Tn_ - 64 * (c_ + 1), pos_ = dir == 0 ? t0_ + s : t0_ + 63 - s; \
            const bf16* qg_ = (ic_ ? QGc + (size_t)(b * TC + pos_) * 2048 : QGl + (size_t)(b * TL + pos_) * 2048) + dir * 1024 + h * 128 + cg * 16; \
            rq0 = *(const v4u*)(qg_); rq1 = *(const v4u*)(qg_ + 8); rk0 = *(const v4u*)(qg_ + 512); rk1 = *(const v4u*)(qg_ + 520); \
            if (cg < 4) { const bf16* pv_ = F.P16 + (size_t)((ic_ ? ML + b * TC : b * TL) + pos_) * PLD + 1024 + h * 256 + e0 + cg * 16; rv0 = *(const v4u*)(pv_); rv1 = *(const v4u*)(pv_ + 8); } \
            const int blk_ = ic_ ? 256 + b * 4 + (t0_ >> 6) : b * 32 + (t0_ >> 6); \
            _Pragma("unroll") for (int k_ = 0; k_ < 4; ++k_) egn[k_] = EGL[(size_t)blk_ * 1024 + dir * 512 + h * 128 + 16 * ((wave & 1) * 4 + k_) + fr]; } while (0)
        GLA_LOAD(0);
        for (int step = 0; step < 36; ++step) {
            const int p = step & 1;
            LAS bf16* Qg = (LAS bf16*)(F.lds + p * 44032);
            LAS bf16* Kg = (LAS bf16*)(F.lds + p * 44032 + 17408);
            LAS bf16* Vs = (LAS bf16*)(F.lds + p * 44032 + 34816);
            const LAS bf16* STr = (const LAS bf16*)(F.lds + 88064 + p * 17408);
            LAS bf16* STw = (LAS bf16*)(F.lds + 88064 + (p ^ 1) * 17408);
            const bool isctx = step < 4; const int c = isctx ? step : step - 4; const int Tn = isctx ? TC : TL;
            const int rowbase = isctx ? ML + b * TC : b * TL;
            const int t0 = dir == 0 ? c * 64 : Tn - 64 * (c + 1);
            *(LAS v4u*)(Qg + s * 136 + cg * 16) = rq0; *(LAS v4u*)(Qg + s * 136 + cg * 16 + 8) = rq1;
            *(LAS v4u*)(Kg + s * 136 + cg * 16) = rk0; *(LAS v4u*)(Kg + s * 136 + cg * 16 + 8) = rk1;
            if (cg < 4) { *(LAS v4u*)(Vs + s * 72 + cg * 16) = rv0; *(LAS v4u*)(Vs + s * 72 + cg * 16 + 8) = rv1; }
#pragma unroll
            for (int k = 0; k < 4; ++k) egc[k] = egn[k];
            if (step + 1 < 36) GLA_LOAD(step + 1);
            asm volatile("s_waitcnt lgkmcnt(0)" ::: "memory"); __builtin_amdgcn_s_barrier(); asm volatile("" ::: "memory");
            {
                const int jt = wave >> 1, ep = (wave & 1) * 2;
                bf16x8 qb[4];
#pragma unroll
                for (int ks = 0; ks < 4; ++ks) qb[ks] = ldfrag(Qg, 136, 16 * jt, 32 * ks, lane);
                f32x4 oT[2];
                {
                    bf16x8 sf[8];
#pragma unroll
                    for (int t2 = 0; t2 < 2; ++t2)
#pragma unroll
                        for (int ks = 0; ks < 4; ++ks) sf[t2 * 4 + ks] = ldfrag(STr, 136, 16 * (ep + t2), 32 * ks, lane);
                    PIN4(qb[0], qb[1], qb[2], qb[3]); PIN8(sf[0], sf[1], sf[2], sf[3], sf[4], sf[5], sf[6], sf[7]);
                    f32x4 o0 = {0.f, 0.f, 0.f, 0.f}, o1 = o0, o2 = o0, o3 = o0;
                    o0 = MFMA16(sf[0], qb[0], o0); o1 = MFMA16(sf[4], qb[0], o1); o2 = MFMA16(sf[1], qb[1], o2); o3 = MFMA16(sf[5], qb[1], o3);
                    o0 = MFMA16(sf[2], qb[2], o0); o1 = MFMA16(sf[6], qb[2], o1); o2 = MFMA16(sf[3], qb[3], o2); o3 = MFMA16(sf[7], qb[3], o3);
                    oT[0] = o0 + o2; oT[1] = o1 + o3;
                }
                for (int sp = 0; sp <= (jt >> 1); ++sp) {
                    const int ts0 = 2 * sp, ts1 = 2 * sp + 1;
                    bf16x8 kf[8];
#pragma unroll
                    for (int ks = 0; ks < 4; ++ks) { kf[ks] = ldfrag(Kg, 136, 16 * ts0, 32 * ks, lane); kf[4 + ks] = ldfrag(Kg, 136, 16 * ts1, 32 * ks, lane); }
                    bf16x8 vf0 = ldfrag_tr4(Vs, 72, 32 * sp, 16 * ep, lane), vf1 = ldfrag_tr4(Vs, 72, 32 * sp, 16 * (ep + 1), lane);
                    PIN8(kf[0], kf[1], kf[2], kf[3], kf[4], kf[5], kf[6], kf[7]); PIN2(vf0, vf1);
                    f32x4 aT0 = {0.f, 0.f, 0.f, 0.f}, aT1 = aT0, aT2 = aT0, aT3 = aT0;
                    aT0 = MFMA16(kf[0], qb[0], aT0); aT1 = MFMA16(kf[4], qb[0], aT1); aT2 = MFMA16(kf[1], qb[1], aT2); aT3 = MFMA16(kf[5], qb[1], aT3);
                    aT0 = MFMA16(kf[2], qb[2], aT0); aT1 = MFMA16(kf[6], qb[2], aT1); aT2 = MFMA16(kf[3], qb[3], aT2); aT3 = MFMA16(kf[7], qb[3], aT3);
                    aT0 = aT0 + aT2; aT1 = aT1 + aT3;
#pragma unroll
                    for (int reg = 0; reg < 4; ++reg) { const bool v0 = (ts0 < jt) || (4 * fq + reg <= fr), v1 = (ts1 < jt) || (ts1 == jt && 4 * fq + reg <= fr);
                        aT0[reg] = v0 ? aT0[reg] : 0.f; aT1[reg] = v1 ? aT1[reg] : 0.f; }
                    const bf16x8 pf = cvt8_mma(aT0[0], aT0[1], aT0[2], aT0[3], aT1[0], aT1[1], aT1[2], aT1[3]);
                    oT[0] = MFMA16(vf0, pf, oT[0]); oT[1] = MFMA16(vf1, pf, oT[1]);
                }
                const int jj = 16 * jt + fr; const int pos = dir == 0 ? t0 + jj : t0 + 63 - jj;
                bf16* op = Oout + (size_t)(rowbase + pos) * D + h * 256 + e0 + 4 * fq;
#pragma unroll
                for (int t2 = 0; t2 < 2; ++t2) { v2u w; w.x = pk2(oT[t2][0], oT[t2][1]); w.y = pk2(oT[t2][2], oT[t2][3]); *(v2u*)(op + 16 * (ep + t2)) = w; }
            }
            {
                const int et = wave >> 1;
                bf16x8 va0 = ldfrag_tr(Vs, 72, 0, 16 * et, lane), va1 = ldfrag_tr(Vs, 72, 32, 16 * et, lane);
                bf16x8 kb[8];
#pragma unroll
                for (int k = 0; k < 4; ++k) { const int dt = (wave & 1) * 4 + k; kb[2 * k] = ldfrag_tr(Kg, 136, 0, 16 * dt, lane); kb[2 * k + 1] = ldfrag_tr(Kg, 136, 32, 16 * dt, lane); }
                PIN2(va0, va1); PIN8(kb[0], kb[1], kb[2], kb[3], kb[4], kb[5], kb[6], kb[7]);
#pragma unroll
                for (int k = 0; k < 4; ++k) st[k] = MFMA16(va0, kb[2 * k], st[k]);
#pragma unroll
                for (int k = 0; k < 4; ++k) st[k] = MFMA16(va1, kb[2 * k + 1], st[k]);
#pragma unroll
                for (int k = 0; k < 4; ++k) { const int dt = (wave & 1) * 4 + k; st[k] = st[k] * egc[k];
#pragma unroll
                    for (int reg = 0; reg < 4; ++reg) STw[(16 * et + 4 * fq + reg) * 136 + 16 * dt + fr] = (bf16)f2bf(st[k][reg]); }
            }
        }
#undef GLA_LOAD
    }
}
__device__ __forceinline__ void gla_combine_phase(Frame& F, const Args& A, int nrows) {
    const int gw = F.mi * NWAVES + F.wave, NGW = 32 * NWAVES, nloc = nrows == MT ? TL + TC : TL;
    float ng[16];
#pragma unroll
    for (int i = 0; i < 16; ++i) ng[i] = A.in[20][(F.lane & 15) * 16 + i];
    for (int lr = gw; lr < nloc; lr += NGW) { const int row = grow(F, lr);
        bf16* of = F.H16 + (size_t)row * D + F.lane * 16; const bf16* ob = F.HB16 + (size_t)row * D + F.lane * 16; const bf16* rr = F.P16 + (size_t)row * PLD + 2048 + F.lane * 16;
        float o[16], a[8], b2[8]; float ss = 0.f;
#pragma unroll
        for (int hv = 0; hv < 2; ++hv) { unpack8(*(const v4u*)(of + hv * 8), a); unpack8(*(const v4u*)(ob + hv * 8), b2);
#pragma unroll
            for (int i = 0; i < 8; ++i) { o[hv * 8 + i] = a[i] + b2[i]; ss += o[hv * 8 + i] * o[hv * 8 + i]; } }
        ss += __shfl_xor(ss, 1); ss += __shfl_xor(ss, 2); ss += __shfl_xor(ss, 4); ss += __shfl_xor(ss, 8);
        const float rinv = 1.0f / sqrtf(ss * (1.f / 256.f) + EPS);
#pragma unroll
        for (int hv = 0; hv < 2; ++hv) { float g[8], y[8]; unpack8(*(const v4u*)(rr + hv * 8), g);
#pragma unroll
            for (int i = 0; i < 8; ++i) y[i] = o[hv * 8 + i] * rinv * ng[hv * 8 + i] * siluf_(g[i]);
            *(v4u*)(of + hv * 8) = pack8(y); }
    }
}

#define NA_SOFTMAX_PV(LOC_, VT_, S0_) do { \
        float sv[8]; float gmax = -INFINITY; \
        _Pragma("unroll") for (int t = 0; t < 2; ++t) _Pragma("unroll") for (int reg = 0; reg < 4; ++reg) { float x = (t == 0 ? sT0[reg] : sT1[reg]) * 0.125f; \
            if (LOC_) { const int col_k = kst + 16 * t + 4 * fq + reg; const bool valid = (col_k >= cst) && (col_k < cst + 16); \
                const int dc = min(max(col_k - col_q + 15, 0), 30), dr = rs + gi - r + 7; x = valid ? x + rpb[dr * 31 + dc] : -INFINITY; } \
            sv[t * 4 + reg] = x; gmax = fmaxf(gmax, x); } \
        gmax = fmaxf(gmax, __shfl_xor(gmax, 16)); gmax = fmaxf(gmax, __shfl_xor(gmax, 32)); \
        const float m_new = fmaxf(m_run, gmax), alpha = __expf(m_run - m_new); \
        float ps = 0.f; float pv[8]; \
        _Pragma("unroll") for (int i = 0; i < 8; ++i) { pv[i] = __expf(sv[i] - m_new); ps += pv[i]; } \
        l_part = l_part * alpha + ps; m_run = m_new; \
        const bf16x8 pf = cvt8_mma(pv[0], pv[1], pv[2], pv[3], pv[4], pv[5], pv[6], pv[7]); \
        _Pragma("unroll") for (int et = 0; et < 4; ++et) oT[et] = oT[et] * alpha; \
        oT[0] = MFMA16(vf0, pf, oT[0]); oT[1] = MFMA16(vf1, pf, oT[1]); oT[2] = MFMA16(vf2, pf, oT[2]); oT[3] = MFMA16(vf3, pf, oT[3]); } while (0)
__device__ __forceinline__ void na_phase(Frame& F, const Args& A) {
    LAS bf16* Vl = (LAS bf16*)(F.lds + 0);
    LAS bf16* Vc = (LAS bf16*)(F.lds + 82944);
    LAS bf16* Kc = (LAS bf16*)(F.lds + 119808);
    LAS float* rpb = (LAS float*)(F.lds + 156672);
    const int tid = F.tid, lane = F.lane, wave = F.wave, fr = lane & 15, fq = lane >> 4;
    const bf16* P = F.P16;
    for (int wg = F.vcu; wg < 256; wg += F.G) {
        const int bh = wg >> 1, b = bh >> 4, h = bh & 15, odd = wg & 1;
        __syncthreads();
        for (int it = tid; it < 256 * 8; it += NTHR) { const int tok = it >> 3, eg = it & 7; const bf16* src = P + (size_t)(ML + b * TC + tok) * PLD + h * 64 + eg * 8;
            *(LAS v4u*)(Vc + tok * 72 + eg * 8) = *(const v4u*)(src + 2048); *(LAS v4u*)(Kc + tok * 72 + eg * 8) = *(const v4u*)(src + 1024); }
        for (int i = tid; i < 465; i += NTHR) rpb[i] = A.in[23][h * 465 + i];
        int have_hi = -1;
        for (int si = 0; si < 9; ++si) { const int sub = si < 8 ? odd * 8 + si : 16 + odd;
            const bool lat = sub < 16;
            const int rp = lat ? sub : 0, half = lat ? 0 : sub - 16;
            const int r0 = 2 * rp, rs0 = min(max(r0 - 4, 0), 24), nrw = min(9, 32 - rs0);
            const int r = r0 + (wave >> 2), n = wave & 3;
            const int rs = min(max(r - 4, 0), 24), kst = min(max(16 * n - 8, 0), 32);
            const int qrow = lat ? b * TL + r * 64 + 16 * n + fr : ML + b * TC + 16 * (half * 8 + wave) + fr;
            const bf16x8 qf0 = *(const bf16x8*)(P + (size_t)qrow * PLD + h * 64 + 8 * fq), qf1 = *(const bf16x8*)(P + (size_t)qrow * PLD + h * 64 + 32 + 8 * fq);
            bf16x8 ka[4], kb[4];
#define NA_KLOAD(kd_, gi_) do { const bf16* kp_ = P + (size_t)(b * TL + (rs + (gi_)) * 64 + kst + fr) * PLD + 1024 + h * 64 + 8 * fq; \
                    kd_[0] = *(const bf16x8*)(kp_); kd_[1] = *(const bf16x8*)(kp_ + 32); kd_[2] = *(const bf16x8*)(kp_ + (size_t)16 * PLD); kd_[3] = *(const bf16x8*)(kp_ + (size_t)16 * PLD + 32); } while (0)
            if (lat) { NA_KLOAD(ka, 0); NA_KLOAD(kb, 1); }
            asm volatile("s_waitcnt lgkmcnt(0)" ::: "memory"); __builtin_amdgcn_s_barrier(); asm volatile("" ::: "memory");
            if (lat) {
                const int lo = have_hi < 0 ? rs0 : max(rs0, have_hi), hi = rs0 + nrw;
                for (int it = tid; it < (hi - lo) * 64 * 8; it += NTHR) { const int rw = lo + (it >> 9), tk = (it >> 3) & 63, eg = it & 7;
                    *(LAS v4u*)(Vl + ((rw % 9) * 64 + tk) * 72 + eg * 8) = *(const v4u*)(P + (size_t)(b * TL + rw * 64 + tk) * PLD + 2048 + h * 64 + eg * 8); }
                have_hi = hi;
            }
            asm volatile("s_waitcnt lgkmcnt(0)" ::: "memory"); __builtin_amdgcn_s_barrier(); asm volatile("" ::: "memory");
            const int col_q = 16 * n + fr, cst = min(max(col_q - 8, 0), 48);
            float m_run = -INFINITY, l_part = 0.f;
            f32x4 oT[4];
#pragma unroll
            for (int et = 0; et < 4; ++et) oT[et] = (f32x4){0.f, 0.f, 0.f, 0.f};
            if (lat) {
#define NA_WGROUP(kd_, gi_) do { const int gi = (gi_); const bf16x8 k00 = kd_[0], k01 = kd_[1], k10 = kd_[2], k11 = kd_[3]; \
                    if (gi + 2 < 8) NA_KLOAD(kd_, gi + 2); \
                    const int s0 = ((rs + gi) % 9) * 64 + kst; \
                    bf16x8 vf0 = ldfrag_tr4(Vl, 72, s0, 0, lane), vf1 = ldfrag_tr4(Vl, 72, s0, 16, lane), vf2 = ldfrag_tr4(Vl, 72, s0, 32, lane), vf3 = ldfrag_tr4(Vl, 72, s0, 48, lane); \
                    f32x4 sT0 = {0.f, 0.f, 0.f, 0.f}, sT1 = sT0; \
                    sT0 = MFMA16(k00, qf0, sT0); sT1 = MFMA16(k10, qf0, sT1); sT0 = MFMA16(k01, qf1, sT0); sT1 = MFMA16(k11, qf1, sT1); \
                    NA_SOFTMAX_PV(true, Vl, s0); } while (0)
#pragma unroll 1
                for (int g2 = 0; g2 < 8; g2 += 2) { NA_WGROUP(ka, g2); NA_WGROUP(kb, g2 + 1); }
#undef NA_WGROUP
#undef NA_KLOAD
            }
#pragma unroll 1
            for (int gc = 0; gc < 8; ++gc) {
                const int gi = 8 + gc; (void)gi;
                bf16x8 k00 = ldfrag(Kc, 72, 32 * gc, 0, lane), k01 = ldfrag(Kc, 72, 32 * gc, 32, lane), k10 = ldfrag(Kc, 72, 32 * gc + 16, 0, lane), k11 = ldfrag(Kc, 72, 32 * gc + 16, 32, lane);
                bf16x8 vf0 = ldfrag_tr4(Vc, 72, 32 * gc, 0, lane), vf1 = ldfrag_tr4(Vc, 72, 32 * gc, 16, lane), vf2 = ldfrag_tr4(Vc, 72, 32 * gc, 32, lane), vf3 = ldfrag_tr4(Vc, 72, 32 * gc, 48, lane);
                PIN4(k00, k01, k10, k11);
                f32x4 sT0 = {0.f, 0.f, 0.f, 0.f}, sT1 = sT0;
                sT0 = MFMA16(k00, qf0, sT0); sT1 = MFMA16(k10, qf0, sT1); sT0 = MFMA16(k01, qf1, sT0); sT1 = MFMA16(k11, qf1, sT1);
                NA_SOFTMAX_PV(false, Vc, 0);
            }
            float l = l_part; l += __shfl_xor(l, 16); l += __shfl_xor(l, 32);
            const float inv = 1.0f / l;
            bf16* op = F.H16 + (size_t)qrow * D + h * 64 + 4 * fq;
#pragma unroll
            for (int et = 0; et < 4; ++et) { v2u w; w.x = pg8::cvt_pk_bf16(oT[et][0] * inv, oT[et][1] * inv); w.y = pg8::cvt_pk_bf16(oT[et][2] * inv, oT[et][3] * inv); *(v2u*)(op + 16 * et) = w; }
        }
    }
}
constexpr int N_PHASES = 42;

#ifndef STAG
#define STAG 1
#endif
#ifndef SLP
#define SLP 64
#endif
#ifndef GSTAG
#define GSTAG 0
#endif
template <class Epi, bool SWAP>
__device__ __forceinline__ void run_gemm(Frame& F, const bf16* A, const bf16* Bt, int npan, int N, int K, const Epi& E) {
    pg8::Gemm g{A, Bt, MT, N, K}; GroupOrder S; S.g = F.grp; S.mi = F.mi; S.npan = npan; S.nN = N / 256; S.ntK = K / 64; S.wid = F.wave;
    if (STAG) {
        const int rem = (npan * (N / 256)) % 32;
        if (rem != 0 && F.mi >= rem) { const int st = ((F.mi - rem) & 3) + 1; for (int i = 0; i < st * STAG; ++i) __builtin_amdgcn_s_sleep(SLP); }
    }
    pg8::gemm_phase<Epi, GroupOrder, true, true, SWAP>(F.lds, g, S, E);
}
__device__ __forceinline__ void run_resid_gemm(Frame& F, const bf16* A, const bf16* Bt, int K, bool with_ctx, const float* gate, float* slab) {
    pg8::Gemm g{A, Bt, MT, D, K}; GroupSplitOrder S; S.g = F.grp; S.mi = F.mi; S.ntK = K / 64; S.np = with_ctx ? (K == D ? 16 : 32) : 0; S.wid = F.wave; EpiResidSplit E{F.X, gate, slab, 0};
    pg8::gemm_phase<EpiResidSplit, GroupSplitOrder, true, true, false>(F.lds, g, S, E);
}
__global__ void __launch_bounds__(NTHR, 2) fwd_kernel(Args args) {
    extern __shared__ __attribute__((aligned(16))) unsigned char lds_raw[];
    Frame F;
    F.lds = (LAS unsigned char*)lds_raw;
    F.wave = __builtin_amdgcn_readfirstlane((int)threadIdx.x >> 6); F.lane = lane_id_now(); F.tid = F.wave * 64 + F.lane;
    F.G = gridDim.x; { const int bx = blockIdx.x; F.vcu = (bx % 8) * 32 + bx / 8; }
    F.grp = F.vcu >> 5; F.mi = F.vcu & 31; F.gph = 0u;
    F.ws = args.ws;
    F.X = (bf16*)(args.ws + WS_X); F.H16 = (bf16*)(args.ws + WS_H16); F.HB16 = (bf16*)(args.ws + WS_HB16); F.P16 = (bf16*)(args.ws + WS_P16);
    F.G32 = (float*)(args.ws + WS_G32); F.EDGE = (float*)(args.ws + WS_EDGE); F.MOD = (float*)(args.ws + WS_MOD);
    volatile LAS unsigned* MISC = (volatile LAS unsigned*)(F.lds + MISC_OFF);
    for (int u = F.tid; u < 128; u += NTHR) MISC[u] = 0u;
    __syncthreads();
    unsigned* bw = (unsigned*)(args.ws + WS_CTL) + 4096;
    XcdBarrier bar = xcd_barrier_post(bw, MISC + 8, F.wave == 0);
#define GSEAM() do { F.lane = lane_id_now(); F.tid = F.wave * 64 + F.lane; grp_barrier(bw, F.grp, F.gph, F.tid, F.same_l2); } while (0)
#define RELANE() do { F.lane = lane_id_now(); F.tid = F.wave * 64 + F.lane; } while (0)

    if (F.tid == 0) __hip_atomic_store(&bw[GB_XID(F.vcu)], xb_xcc_id() + 1u, __ATOMIC_RELAXED, __HIP_MEMORY_SCOPE_AGENT);
    convert_layer_weights(F, args, 0, F.vcu * NWAVES + F.wave, F.G * NWAVES); p0_adaln(F, args, 0, F.vcu, F.G);
    xcd_barrier(bar);
    { const unsigned v = xb_ld(&bw[GB_XID(F.grp * 32 + (lane_id_now() & 31))]); F.same_l2 = __all(v == xb_xcc_id() + 1u) != 0; }
    for (int i = 0; i < F.grp * GSTAG; ++i) __builtin_amdgcn_s_sleep(SLP);

    float* slab = (float*)(args.ws + WS_SLAB); float* EGL = (float*)(args.ws + WS_EGL);
    for (int layer = 0; layer < DEPTH; ++layer) {
        RELANE();
        const int kind = layer % 3, jk = layer / 3;
        const bool last = layer == DEPTH - 1;
        const int Mff = last ? ML : MT, npan = last ? 8 : 9;
        const float* modl = F.MOD + (size_t)layer * 9 * 6144;
        const int nN_in = kind == 2 ? 12 : 13;
        if (layer > 0) { const int pk = (layer - 1) % 3, pu = 9 * (pk == 2 ? 12 : 13), prem = pu % 32; flag_wait(bw, FL_M(layer), 8u * (unsigned)(prem == 0 ? 32 : 32 - prem), F.tid); }
        RELANE(); norm_phase(F, args, layer, 0, layer == 0, MT, layer > 0 ? slab : nullptr, F.MOD + (size_t)((layer > 0 ? layer - 1 : 0) * 9 + 8) * 6144 + 5120); GSEAM();
        if (layer > 0) { const int prem = (9 * 22) % 32; flag_wait(bw, FL_W(layer), 8u * (unsigned)(32 - prem), F.tid); }
        { RELANE();
            EpiInproj E{F.P16, F.G32};
            run_gemm<EpiInproj, false>(F, F.H16, wb_ptr(F, layer, WB_IN), 9, nN_in * 256, D, E);
            if (!last) {
                const int rem = (9 * nN_in) % 32, nidle = rem == 0 ? 32 : 32 - rem, iidx = rem == 0 ? F.mi : F.mi - rem;
                if (iidx >= 0) { p0_adaln(F, args, layer + 1, F.grp * nidle + iidx, 8 * nidle); flag_signal(bw, FL_M(layer + 1), F.tid); }
            }
            GSEAM();
        }
        bf16* QKl = kind == 0 ? (bf16*)args.out + (size_t)F.grp * TL * D : (bf16*)args.out;
        bf16* QKc = (bf16*)(args.ws + WS_SCR);
        if (kind == 0) { RELANE(); mlstm_prep_phase(F, args, jk, QKl, QKc); GSEAM(); }
        else if (kind == 1) { RELANE(); gla_prep_phase(F, args, QKl, QKc, EGL); GSEAM(); }
        { RELANE();
            if (kind == 0) mlstm_phase(F, args, jk, QKl, QKc, (f32x4*)(args.ws + WS_GATES));
            else if (kind == 1) gla_phase(F, args, QKl, QKc, EGL);
            else na_phase(F, args);
            GSEAM();
        }
        if (kind == 0) { RELANE(); mlstm_combine_phase(F, args, Mff); GSEAM(); }
        else if (kind == 1) { RELANE(); gla_combine_phase(F, args, Mff); GSEAM(); }
        { RELANE(); run_resid_gemm(F, F.H16, wb_ptr(F, layer, WB_OUT), D, !last, modl + 2048, slab); GSEAM(); }
        { RELANE(); norm_phase(F, args, layer, 1, false, Mff, last ? nullptr : slab, modl + (size_t)8 * 6144 + 2048); GSEAM(); }
        { RELANE();
            EpiConvGate E{F.P16, F.EDGE, args.in[9] + (size_t)layer * 3 * FF2, args.in[10] + (size_t)layer * FF2, (LAS float*)(F.lds + CE_OFF)};
            run_gemm<EpiConvGate, true>(F, F.H16, wb_ptr(F, layer, WB_UP), npan, FF2, D, E);
            if (!last) {
                const int rem = (npan * 22) % 32, nidle = rem == 0 ? 32 : 32 - rem, iidx = rem == 0 ? F.mi : F.mi - rem;
                if (iidx >= 0) { convert_layer_weights(F, args, layer + 1, (F.grp * nidle + iidx) * NWAVES + F.wave, 8 * nidle * NWAVES); flag_signal(bw, FL_W(layer + 1), F.tid); }
            }
            GSEAM();
        }
        { RELANE(); ffn_fixup_phase(F, args, layer); GSEAM(); }
        { RELANE(); run_resid_gemm(F, F.P16, wb_ptr(F, layer, WB_DN), FF, !last, modl + 5120, slab); GSEAM(); }
    }
    RELANE(); final_norm_phase(F, args);
#undef GSEAM
#undef RELANE
}

#ifndef MK_PER_PHASE
#define MK_PER_PHASE 0
#endif
extern "C" void kernel_launch(void* const* d_in, const int* in_sizes, int n_in, void* d_out, int out_size, void* d_ws, size_t ws_size, hipStream_t stream) {
    static int grid = 0;
    if (grid == 0) {
        if (n_in != 26 || out_size != ML * D || ws_size < WS_END) { fprintf(stderr, "kernel_launch: unexpected shapes: n_in %d out %d ws %zu (need %zu)\n", n_in, out_size, ws_size, (size_t)WS_END); grid = -1; return; }
        int dev = 0, cus = 0, per_cu = 0;
        if (hipGetDevice(&dev) != hipSuccess || hipDeviceGetAttribute(&cus, hipDeviceAttributeMultiprocessorCount, dev) != hipSuccess) { grid = -1; return; }
        if (hipFuncSetAttribute((const void*)fwd_kernel, hipFuncAttributeMaxDynamicSharedMemorySize, LDS_BYTES) != hipSuccess) { fprintf(stderr, "kernel_launch: hipFuncSetAttribute failed\n"); grid = -1; return; }
        if (hipOccupancyMaxActiveBlocksPerMultiprocessor(&per_cu, (const void*)fwd_kernel, NTHR, LDS_BYTES) != hipSuccess || per_cu < 1) { fprintf(stderr, "kernel_launch: occupancy query failed (%d)\n", per_cu); (void)hipGetLastError(); grid = -1; return; }
        if (cus < 256) { fprintf(stderr, "kernel_launch: needs 256 compute units (8 batch groups of 32 workgroups), found %d\n", cus); grid = -1; return; }
        grid = 256;
        fprintf(stderr, "kernel_launch: grid %d (cus %d, occupancy %d per CU)\n", grid, cus, per_cu);
    }
    if (grid < 0) return;
    if (hipMemsetAsync((char*)d_ws + WS_CTL, 0, CTL_ZERO_BYTES, stream) != hipSuccess) return;
    Args a{};
    for (int i = 0; i < 26; ++i) a.in[i] = (const float*)d_in[i];
    a.out = (float*)d_out; a.ws = (unsigned char*)d_ws;
#if 0
#else
    a.ph_lo = 0; a.ph_hi = N_PHASES;
#ifdef MK_PLAIN_LAUNCH
    hipLaunchKernelGGL(fwd_kernel, dim3(grid), dim3(NTHR), LDS_BYTES, stream, a);
#else
    void* kargs[] = {&a};
    hipError_t e = hipLaunchCooperativeKernel((const void*)fwd_kernel, dim3(grid), dim3(NTHR), kargs, LDS_BYTES, stream);
    if (e != hipSuccess) fprintf(stderr, "kernel_launch: cooperative launch failed: %s (grid %d)\n", hipGetErrorString(e), grid);
#endif
#endif
}
```

```cpp
#include <hip/hip_runtime.h>
#include <cstdio>
#include <cstdint>
namespace pg8 {
#define PG8_LAS __attribute__((address_space(3)))
typedef unsigned short bf16_t;
typedef short bf16x8 __attribute__((ext_vector_type(8)));
typedef float f32x4 __attribute__((ext_vector_type(4)));
typedef unsigned u32x4 __attribute__((ext_vector_type(4)));
constexpr int BM = 256, BK = 64, HALF = 128, HTB = HALF * BK * 2  , STAGE_BYTES = 8 * HTB, NXCD = 8, WGM = 8;

__host__ __device__ __forceinline__ int lds_byte(int r, int c) { const int st = (r >> 4) * 2 + (c >> 5), rr = r & 15, cc = c & 31, ob = rr * 64 + cc * 2; return st * 1024 + (ob ^ (((ob >> 9) & 1) << 5)); }
__host__ __device__ __forceinline__ void stage_rc(int b, int& R, int& C) { const int st = b / 1024, sb = b % 1024, swz = sb ^ (((sb >> 9) & 1) << 5); R = (st >> 1) * 16 + swz / 64; C = (st & 1) * 32 + (swz % 64) / 2; }
__host__ __device__ __forceinline__ int perm32(int rho) { const int n = rho >> 4, i = rho & 15; return 8 * (i >> 2) + 4 * n + (i & 3); }

struct Unit { int pm, pn, k0, nt; };
struct Gemm { const bf16_t* A; const bf16_t* Bt; int M, N, K; };

struct StaticOrder {
    int nM, nN, nwg, G, c, ntK, wid;
    __host__ __device__ void init(int M, int N, int G_, int c_) { nM = M / BM; nN = N / BM; nwg = nM * nN; G = G_; c = c_; }
    __host__ __device__ bool next(int i, Unit& u) const {
        const long L = (long)i * G + c; if (L >= nwg) return false;
        int wgid = (int)L; { const int q = nwg / NXCD, r = nwg % NXCD, xcd = wgid % NXCD, off = wgid / NXCD; wgid = (xcd < r ? xcd * (q + 1) : r * (q + 1) + (xcd - r) * q) + off; }
        const int nig = WGM * nN, gid = wgid / nig, fm = gid * WGM, gsz = (nM - fm) < WGM ? (nM - fm) : WGM;
        u.pm = fm + ((wgid % nig) % gsz); u.pn = (wgid % nig) / gsz; u.k0 = 0; u.nt = ntK; return true;
    }
    __device__ __forceinline__ void a_ready(const Unit&) const {}
    __device__ __forceinline__ void done(const Unit&) const {}
};


__device__ __forceinline__ unsigned cvt_pk_bf16(float lo, float hi) { unsigned r; asm volatile("v_cvt_pk_bf16_f32 %0, %1, %2" : "=v"(r) : "v"(lo), "v"(hi)); return r; }

template <class Epi, class Sched, bool ALIGN_EPI = false, bool SP2 = false, bool SWAP = false>
__device__ __forceinline__ void gemm_phase(PG8_LAS unsigned char* lds, const Gemm g, const Sched& S, const Epi& E) {
    const int wid = S.wid, wr = wid >> 2, wc = wid & 3;
    const int K = g.K; int nt;
    const size_t kstep = (size_t)(BK * 2);
    const size_t hstep = (size_t)HALF * K * 2;
    const size_t tstep = 2 * hstep;
    const unsigned ldsw = (unsigned)wid * 1024u;
    int tid, lane, fr, fq, aoff, boff; unsigned voffA[2], voffB[2];
#define PG8_LANE_SETUP() do { int l_; asm volatile("v_mbcnt_lo_u32_b32 %0, -1, 0\n\tv_mbcnt_hi_u32_b32 %0, -1, %0" : "=v"(l_)); lane = l_; tid = wid * 64 + l_; fr = lane & 15; fq = lane >> 4; \
        _Pragma("unroll") for (int i_ = 0; i_ < 2; ++i_) { int R, C; stage_rc(tid * 16 + i_ * 8192, R, C); const int Rb = Epi::PERM ? ((R & ~31) + perm32(R & 31)) : R; \
            voffA[i_] = (unsigned)(R * K + C) * 2u; voffB[i_] = (unsigned)(Rb * K + C) * 2u; } \
        aoff = lds_byte(wr * 64 + fr, fq * 8); boff = lds_byte(wc * 32 + fr, fq * 8); } while (0)
    PG8_LANE_SETUP();
#define PG8_SA(b, h) (((b) * 2 + (h)) * HTB)
#define PG8_SB(b, h) ((4 + (b) * 2 + (h)) * HTB)
#define PG8_STAGE(bufoff, gbase, voff) do { _Pragma("unroll") for (int _i = 0; _i < 2; ++_i) \
        __builtin_amdgcn_global_load_lds((const unsigned*)((const char*)(gbase) + (voff)[_i]), (PG8_LAS unsigned*)(lds + (bufoff) + ldsw + _i * 8192), 16, 0, 0); } while (0)
#define PG8_LDA(dst, b, h) do { _Pragma("unroll") for (int m = 0; m < 4; ++m) _Pragma("unroll") for (int k = 0; k < 2; ++k) dst[m][k] = *(const PG8_LAS bf16x8*)(lds + PG8_SA(b, h) + aoff + m * 2048 + k * 1024); } while (0)
#define PG8_LDB(dst, b, h) do { _Pragma("unroll") for (int n = 0; n < 2; ++n) _Pragma("unroll") for (int k = 0; k < 2; ++k) dst[n][k] = *(const PG8_LAS bf16x8*)(lds + PG8_SB(b, h) + boff + n * 2048 + k * 1024); } while (0)
#define PG8_MMA(ai, bj, At, Bt) do { __builtin_amdgcn_s_setprio(1); _Pragma("unroll") for (int m = 0; m < 4; ++m) _Pragma("unroll") for (int n = 0; n < 2; ++n) _Pragma("unroll") for (int k = 0; k < 2; ++k) \
        acc[ai][bj][m][n] = SWAP ? __builtin_amdgcn_mfma_f32_16x16x32_bf16(At[m][k], Bt[n][k], acc[ai][bj][m][n], 0, 0, 0) : __builtin_amdgcn_mfma_f32_16x16x32_bf16(Bt[n][k], At[m][k], acc[ai][bj][m][n], 0, 0, 0); __builtin_amdgcn_s_setprio(0); } while (0)
#define PG8_WAIT_V(n) asm volatile("s_waitcnt vmcnt(" #n ")" ::: "memory")
#define PG8_WAIT_L(n) asm volatile("s_waitcnt lgkmcnt(" #n ")" ::: "memory")
#define PG8_BAR __builtin_amdgcn_s_barrier()
#define PG8_SCHED __builtin_amdgcn_sched_barrier(0)
    Unit cur, nxt; int ui = 0;
    if (!S.next(0, cur)) return;
    nt = cur.nt;
    f32x4 acc[2][2][4][2];
#pragma unroll
    for (int a = 0; a < 2; ++a)
#pragma unroll
        for (int b = 0; b < 2; ++b)
#pragma unroll
            for (int m = 0; m < 4; ++m)
#pragma unroll
                for (int n = 0; n < 2; ++n) acc[a][b][m][n] = (f32x4){0.f, 0.f, 0.f, 0.f};
    bf16x8 At[4][2], B0[2][2], B1[2][2];
    const char* cA = (const char*)g.A + (size_t)cur.pm * tstep + (size_t)cur.k0 * 2; const char* cB = (const char*)g.Bt + (size_t)cur.pn * tstep + (size_t)cur.k0 * 2;
    S.a_ready(cur);
    if constexpr (SP2) {
        PG8_STAGE(PG8_SB(0, 0), cB, voffB); PG8_STAGE(PG8_SB(0, 1), cB + hstep, voffB); PG8_STAGE(PG8_SA(0, 0), cA, voffA); PG8_STAGE(PG8_SA(0, 1), cA + hstep, voffA);
        if (wr == 1) PG8_BAR;
        PG8_WAIT_V(2); PG8_BAR;
        PG8_STAGE(PG8_SB(1, 0), cB + kstep, voffB); PG8_STAGE(PG8_SA(1, 0), cA + kstep, voffA); PG8_STAGE(PG8_SB(1, 1), cB + hstep + kstep, voffB);
        PG8_WAIT_V(6); PG8_BAR;
    } else {
        PG8_STAGE(PG8_SB(0, 0), cB, voffB); PG8_STAGE(PG8_SA(0, 0), cA, voffA); PG8_STAGE(PG8_SB(0, 1), cB + hstep, voffB); PG8_STAGE(PG8_SA(0, 1), cA + hstep, voffA);
        if (wr == 1) PG8_BAR;
        PG8_WAIT_V(4); PG8_BAR;
        PG8_STAGE(PG8_SB(1, 0), cB + kstep, voffB); PG8_STAGE(PG8_SA(1, 0), cA + kstep, voffA); PG8_STAGE(PG8_SB(1, 1), cB + hstep + kstep, voffB);
        PG8_WAIT_V(6); PG8_BAR;
    }
    for (;;) {
        const bool has_next = S.next(ui + 1, nxt);
        const char* nA = has_next ? (const char*)g.A + (size_t)nxt.pm * tstep + (size_t)nxt.k0 * 2 : cA; const char* nB = has_next ? (const char*)g.Bt + (size_t)nxt.pn * tstep + (size_t)nxt.k0 * 2 : cB;
        for (int t = 0; t < nt; t += 2) {
            const bool last = (t == nt - 2);
            const char* a1 = cA + (size_t)(t + 1) * kstep;
            const char* a2 = last ? nA : cA + (size_t)(t + 2) * kstep; const char* b2 = last ? nB : cB + (size_t)(t + 2) * kstep;
            const char* a3 = a2 + kstep; const char* b3 = b2 + kstep;
            if (last && has_next) S.a_ready(nxt);
            if constexpr (SP2) {
            PG8_LDB(B0, 0, 0); PG8_LDB(B1, 0, 1); PG8_SCHED; PG8_LDA(At, 0, 0); PG8_STAGE(PG8_SA(1, 1), a1 + hstep, voffA);
            PG8_WAIT_V(8); PG8_WAIT_L(0); PG8_BAR; PG8_MMA(0, 0, At, B0); PG8_MMA(0, 1, At, B1); PG8_BAR; PG8_SCHED;
            PG8_LDA(At, 0, 1); PG8_STAGE(PG8_SB(0, 0), b2, voffB); PG8_STAGE(PG8_SB(0, 1), b2 + hstep, voffB); PG8_STAGE(PG8_SA(0, 0), a2, voffA);
            PG8_WAIT_V(8); PG8_WAIT_L(0); PG8_BAR; PG8_MMA(1, 0, At, B0); PG8_MMA(1, 1, At, B1); PG8_BAR; PG8_SCHED;
            PG8_LDB(B0, 1, 0); PG8_LDB(B1, 1, 1); PG8_SCHED; PG8_LDA(At, 1, 0); PG8_STAGE(PG8_SA(0, 1), a2 + hstep, voffA);
            PG8_WAIT_V(8); PG8_WAIT_L(0); PG8_BAR; PG8_MMA(0, 0, At, B0); PG8_MMA(0, 1, At, B1); PG8_BAR; PG8_SCHED;
            PG8_LDA(At, 1, 1); PG8_STAGE(PG8_SB(1, 0), b3, voffB); PG8_STAGE(PG8_SB(1, 1), b3 + hstep, voffB); PG8_STAGE(PG8_SA(1, 0), a3, voffA);
            PG8_WAIT_V(8); PG8_WAIT_L(0); PG8_BAR; PG8_MMA(1, 0, At, B0); PG8_MMA(1, 1, At, B1); PG8_BAR; PG8_SCHED;
            } else {
            PG8_LDB(B0, 0, 0); PG8_SCHED; PG8_LDA(At, 0, 0); PG8_STAGE(PG8_SA(1, 1), a1 + hstep, voffA);
            PG8_WAIT_L(8); PG8_BAR; PG8_WAIT_L(0); PG8_MMA(0, 0, At, B0); PG8_BAR; PG8_SCHED;
            PG8_LDB(B1, 0, 1); PG8_STAGE(PG8_SB(0, 0), b2, voffB);
            PG8_BAR; PG8_WAIT_L(0); PG8_MMA(0, 1, At, B1); PG8_BAR;
            PG8_LDA(At, 0, 1); PG8_STAGE(PG8_SA(0, 0), a2, voffA);
            PG8_BAR; PG8_WAIT_L(0); PG8_MMA(1, 0, At, B0); PG8_BAR; PG8_SCHED;
            PG8_STAGE(PG8_SB(0, 1), b2 + hstep, voffB);
            PG8_WAIT_V(6); PG8_BAR; PG8_MMA(1, 1, At, B1); PG8_BAR;
            PG8_LDB(B0, 1, 0); PG8_SCHED; PG8_LDA(At, 1, 0); PG8_STAGE(PG8_SA(0, 1), a2 + hstep, voffA);
            PG8_WAIT_L(8); PG8_BAR; PG8_WAIT_L(0); PG8_MMA(0, 0, At, B0); PG8_BAR; PG8_SCHED;
            PG8_LDB(B1, 1, 1); PG8_STAGE(PG8_SB(1, 0), b3, voffB);
            PG8_BAR; PG8_WAIT_L(0); PG8_MMA(0, 1, At, B1); PG8_BAR;
            PG8_LDA(At, 1, 1); PG8_STAGE(PG8_SA(1, 0), a3, voffA);
            PG8_BAR; PG8_WAIT_L(0); PG8_MMA(1, 0, At, B0); PG8_BAR; PG8_SCHED;
            PG8_STAGE(PG8_SB(1, 1), b3 + hstep, voffB);
            PG8_WAIT_V(6); PG8_BAR; PG8_MMA(1, 1, At, B1); PG8_BAR;
            }
        }
        if constexpr (ALIGN_EPI) { if (wr == 0) PG8_BAR; }
        if constexpr (!Epi::AFTER_DRAIN) { E(acc, cur, wr, wc, fr, fq); S.done(cur); if constexpr (SWAP) PG8_LANE_SETUP(); }
        if (!has_next) break;
#pragma unroll
        for (int a = 0; a < 2; ++a)
#pragma unroll
            for (int b = 0; b < 2; ++b)
#pragma unroll
                for (int m = 0; m < 4; ++m)
#pragma unroll
                    for (int n = 0; n < 2; ++n) acc[a][b][m][n] = (f32x4){0.f, 0.f, 0.f, 0.f};
        cur = nxt; cA = nA; cB = nB; nt = cur.nt; ++ui;
        if constexpr (ALIGN_EPI) { if (wr == 1) PG8_BAR; }
    }
    PG8_WAIT_V(0);
    if constexpr (!ALIGN_EPI) { if (wr == 0) PG8_BAR; }
    PG8_BAR;
    if constexpr (Epi::AFTER_DRAIN) { E.fused(acc, cur, wr, wc, fr, fq, lds, wid, lane); S.done(cur); }
#undef PG8_LANE_SETUP
#undef PG8_SA
#undef PG8_SB
#undef PG8_STAGE
#undef PG8_LDA
#undef PG8_LDB
#undef PG8_MMA
#undef PG8_WAIT_V
#undef PG8_WAIT_L
#undef PG8_BAR
#undef PG8_SCHED
}
}

#define GAS __attribute__((address_space(1)))
#define LAS __attribute__((address_space(3)))
typedef unsigned short bf16;
typedef unsigned v4u __attribute__((ext_vector_type(4)));
typedef unsigned v2u __attribute__((ext_vector_type(2)));
typedef float f32x4 __attribute__((ext_vector_type(4)));
typedef float f32x2 __attribute__((ext_vector_type(2)));
typedef short bf16x8 __attribute__((ext_vector_type(8)));
typedef short bf16x4 __attribute__((ext_vector_type(4)));

constexpr int D = 1024, NB = 8, TL = 2048, TC = 256, DEPTH = 4;
constexpr int ML = NB * TL, MC = NB * TC, MT = ML + MC;
constexpr int FF = 2816, FF2 = 5632;
constexpr int NINP = 3328;
constexpr int PLD = 3072;
constexpr float EPS = 1e-6f;
constexpr int NWAVES = 8, NTHR = 512;

constexpr size_t MiB = 1u << 20;
constexpr size_t WS_CTL = 0, CTL_ZERO_BYTES = 65536;
constexpr size_t WS_MOD = 1 * MiB;
constexpr size_t WS_WB = 2 * MiB;
constexpr size_t WB_LAYER = 25 * MiB, WB_IN = 0, WB_OUT = 6815744, WB_UP = WB_OUT + 2097152, WB_DN = WB_UP + 11534336;
static_assert(WB_DN + 5767168 == WB_LAYER, "weights per layer");
constexpr size_t WS_X = 102 * MiB;
constexpr size_t WS_H16 = 174 * MiB;
constexpr size_t WS_HB16 = 210 * MiB;
constexpr size_t WS_P16 = 246 * MiB;
constexpr size_t WS_G32 = 354 * MiB;
constexpr size_t WS_EDGE = 357 * MiB;
constexpr size_t WS_SCR = 364 * MiB;
constexpr size_t WS_GATES = 372 * MiB;
constexpr size_t WS_SLAB = 138 * MiB;
constexpr size_t WS_EGL = 156 * MiB;
constexpr size_t WS_END = 381 * MiB;

constexpr int LDS_BYTES = 163840;
constexpr int MISC_OFF = LDS_BYTES - 512;
constexpr int CE_OFF = MISC_OFF - 8192;

#define RLX_AGENT __ATOMIC_RELAXED, __HIP_MEMORY_SCOPE_AGENT
#define LDS_WAIT() asm volatile("s_waitcnt lgkmcnt(0)" ::: "memory")
#define VM_WAIT() asm volatile("s_waitcnt vmcnt(0)" ::: "memory")
__device__ __forceinline__ unsigned f2bf(float f) { unsigned u = __builtin_bit_cast(unsigned, f); return (u + 0x7fffu + ((u >> 16) & 1u)) >> 16; }
__device__ __forceinline__ unsigned pk2(float lo, float hi) { return f2bf(lo) | (f2bf(hi) << 16); }
__device__ __forceinline__ unsigned cvtpk(float lo, float hi) { unsigned r; asm("v_cvt_pk_bf16_f32 %0, %1, %2" : "=v"(r) : "v"(lo), "v"(hi)); return r; }
__device__ __forceinline__ float bf2f(unsigned h) { return __builtin_bit_cast(float, h << 16); }
__device__ __forceinline__ float bflo(unsigned w) { return __builtin_bit_cast(float, w << 16); }
__device__ __forceinline__ float bfhi(unsigned w) { return __builtin_bit_cast(float, w & 0xffff0000u); }
__device__ __forceinline__ f32x4 ld4bf(const bf16* q) { const v2u w = *(const v2u*)q; return (f32x4){bflo(w.x), bfhi(w.x), bflo(w.y), bfhi(w.y)}; }
__device__ __forceinline__ void unpk8(const v4u w, float* f) { f[0] = bflo(w.x); f[1] = bfhi(w.x); f[2] = bflo(w.y); f[3] = bfhi(w.y); f[4] = bflo(w.z); f[5] = bfhi(w.z); f[6] = bflo(w.w); f[7] = bfhi(w.w); }
__device__ __forceinline__ v4u pk8(const float* f) { v4u w; w.x = pk2(f[0], f[1]); w.y = pk2(f[2], f[3]); w.z = pk2(f[4], f[5]); w.w = pk2(f[6], f[7]); return w; }
__device__ __forceinline__ void st4bf(bf16* q, f32x4 v) { v2u w; w.x = pk2(v.x, v.y); w.y = pk2(v.z, v.w); *(v2u*)q = w; }
__device__ __forceinline__ v4u cvt8_st(float a0, float a1, float a2, float a3, float a4, float a5, float a6, float a7) {
    v4u p;
    asm volatile("v_cvt_pk_bf16_f32 %0, %4, %5\n\tv_cvt_pk_bf16_f32 %1, %6, %7\n\tv_cvt_pk_bf16_f32 %2, %8, %9\n\tv_cvt_pk_bf16_f32 %3, %10, %11\n\ts_nop 0"
                 : "=&v"(p.x), "=&v"(p.y), "=&v"(p.z), "=&v"(p.w) : "v"(a0), "v"(a1), "v"(a2), "v"(a3), "v"(a4), "v"(a5), "v"(a6), "v"(a7));
    return p;
}
__device__ __forceinline__ float sigmoidf_(float x) { return __builtin_amdgcn_rcpf(1.0f + __expf(-x)); }
__device__ __forceinline__ float siluf_(float x) { return x * sigmoidf_(x); }
__device__ __forceinline__ float logsigmoidf_(float x) { return fminf(x, 0.f) - log1pf(__expf(-fabsf(x))); }
__device__ __forceinline__ int lane_id_now() { int l; asm volatile("v_mbcnt_lo_u32_b32 %0, -1, 0\n\tv_mbcnt_hi_u32_b32 %0, -1, %0" : "=v"(l)); return l; }
__device__ __forceinline__ float wave_sum(float v) {
#pragma unroll
    for (int o = 1; o < 64; o <<= 1) v += __shfl_xor(v, o);
    return v;
}

#define XB_TMO      128
#define XB_XCNT(j)  (256  + 64 * (j))
#define XB_XSUB(j)  (1280 + 64 * (j))
#define XB_XGEN(j)  (2304 + 64 * (j))
#define XB_TOP      3328
#define XB_TOPGEN   3392
#define XCD_BAR_WORDS 3456
#define XB_SPIN_CAP (1u << 20)
__device__ __forceinline__ unsigned xb_ld(unsigned* p)              { return __hip_atomic_load(p, __ATOMIC_RELAXED, __HIP_MEMORY_SCOPE_AGENT); }
__device__ __forceinline__ unsigned xb_add(unsigned* p, unsigned v) { return __hip_atomic_fetch_add(p, v, __ATOMIC_RELAXED, __HIP_MEMORY_SCOPE_AGENT); }
__device__ __forceinline__ unsigned xb_xcc_id() { return (unsigned)__builtin_amdgcn_s_getreg((3 << 11) | 20) & 0xFu; }
#define XB_SPIN(cond, bar) do { unsigned _sp = 0; while (cond) { __builtin_amdgcn_s_sleep(1); \
    if ((++_sp & 255u) == 0u) { if (xb_ld(&(bar)[XB_TMO])) break; if (_sp > XB_SPIN_CAP) { atomicAdd(&(bar)[XB_TMO], 1u); break; } } } } while (0)
struct XcdBarrier { unsigned* bar; unsigned x; volatile LAS unsigned* st; bool lead; };
__device__ __forceinline__ XcdBarrier xcd_barrier_post(unsigned* bar, volatile LAS unsigned* st, bool lead0) {
    XcdBarrier b; b.bar = bar; b.x = xb_xcc_id(); b.st = st; b.lead = lead0;
    if (b.lead && lane_id_now() == 0) (void)xb_add(&bar[XB_XCNT(b.x)], 1u);
    return b;
}
__device__ __forceinline__ void xcd_barrier_complete(unsigned* bar, unsigned x, unsigned& nloc, unsigned& nx) {
    const unsigned G = gridDim.x * gridDim.y * gridDim.z;
    unsigned sum, cnt, mine, sp = 0u;
    for (;;) {
        sum = 0u; cnt = 0u; mine = 0u;
#pragma unroll
        for (unsigned j = 0; j < 16; ++j) { const unsigned c = xb_ld(&bar[XB_XCNT(j)]); sum += c; cnt += (c > 0u) ? 1u : 0u; mine = (j == x) ? c : mine; }
        if (sum == G) break;
        __builtin_amdgcn_s_sleep(1);
        if ((++sp & 255u) == 0u) { if (xb_ld(&bar[XB_TMO])) break; if (sp > XB_SPIN_CAP) { atomicAdd(&bar[XB_TMO], 1u); break; } }
    }
    nloc = mine > 0u ? mine : 1u; nx = cnt > 0u ? cnt : 1u;
}
__device__ __forceinline__ void xcd_barrier(const XcdBarrier& b) {
    asm volatile("s_waitcnt vmcnt(0)" ::: "memory");
    __syncthreads();
    if (b.lead && lane_id_now() == 0) {
        unsigned* bar = b.bar;
        __builtin_amdgcn_s_waitcnt(0);
        unsigned nloc = b.st[0], nx = b.st[1];
        if (nloc == 0u) { xcd_barrier_complete(bar, b.x, nloc, nx); b.st[0] = nloc; b.st[1] = nx; }
        const unsigned old = xb_add(&bar[XB_XSUB(b.x)], 1u);
        const unsigned gen = old / nloc;
        if (old + 1u == (gen + 1u) * nloc) {
            __builtin_amdgcn_fence(__ATOMIC_RELEASE, "agent");
            asm volatile("s_waitcnt vmcnt(0)" ::: "memory");
            const unsigned og = xb_add(&bar[XB_TOP], 1u);
            const unsigned tg = og / nx;
            if (og + 1u == (tg + 1u) * nx) xb_add(&bar[XB_TOPGEN], 1u);
            else XB_SPIN(xb_ld(&bar[XB_TOPGEN]) == tg, bar);
            __builtin_amdgcn_fence(__ATOMIC_ACQUIRE, "agent");
            xb_add(&bar[XB_XGEN(b.x)], 1u);
            asm volatile("s_waitcnt vmcnt(0)" ::: "memory");
        } else {
            XB_SPIN(xb_ld(&bar[XB_XGEN(b.x)]) == gen, bar);
            __builtin_amdgcn_fence(__ATOMIC_ACQUIRE, "agent");
            asm volatile("s_waitcnt vmcnt(0)" ::: "memory");
        }
    }
    __syncthreads();
}

#define GB_CNT(g) (4096 + 64 * (g))
#define GB_GEN(g) (4096 + 512 + 64 * (g))
#define FL_W(l)   (4096 + 1024 + 64 * (l))
#define FL_M(l)   (4096 + 1536 + 64 * (l))
#define GB_XID(v) (6144 + (v))
__device__ __forceinline__ void grp_barrier(unsigned* bar, int g, unsigned& ph, int tid, bool same_l2) {
    asm volatile("s_waitcnt vmcnt(0)" ::: "memory");
    __syncthreads();
    if (tid == 0) {
        if (!same_l2) __builtin_amdgcn_fence(__ATOMIC_RELEASE, "agent");
        const unsigned old = xb_add(&bar[GB_CNT(g)], 1u);
        if (old + 1u == 32u * (ph + 1u)) { __hip_atomic_store(&bar[GB_GEN(g)], ph + 1u, __ATOMIC_RELAXED, __HIP_MEMORY_SCOPE_AGENT); }
        else XB_SPIN(xb_ld(&bar[GB_GEN(g)]) < ph + 1u, bar);
        __builtin_amdgcn_fence(__ATOMIC_ACQUIRE, "agent");
    }
    ph += 1u;
    __syncthreads();
}
__device__ __forceinline__ void flag_signal(unsigned* bar, int word, int tid) {
    asm volatile("s_waitcnt vmcnt(0)" ::: "memory");
    __syncthreads();
    if (tid == 0) { __builtin_amdgcn_fence(__ATOMIC_RELEASE, "agent"); xb_add(&bar[word], 1u); }
}
__device__ __forceinline__ void flag_wait(unsigned* bar, int word, unsigned n, int tid) {
    if (tid == 0) { XB_SPIN(xb_ld(&bar[word]) < n, bar); __builtin_amdgcn_fence(__ATOMIC_ACQUIRE, "agent"); }
    __syncthreads();
}

struct Args { const float* in[26]; float* out; unsigned char* ws; int ph_lo, ph_hi; };
struct Frame {
    LAS unsigned char* lds;
    int tid, lane, wave, vcu, G;
    int grp, mi; unsigned gph; bool same_l2;
    unsigned char* ws;
    bf16* X; bf16* H16; bf16* HB16; bf16* P16; float* G32; float* EDGE; float* MOD;
};
__device__ __forceinline__ int grow(const Frame& F, int lr) { return lr < TL ? F.grp * TL + lr : ML + F.grp * TC + (lr - TL); }
__device__ __forceinline__ bf16* wb_ptr(const Frame& F, int layer, size_t off) { return (bf16*)(F.ws + WS_WB + (size_t)layer * WB_LAYER + off); }

__device__ __forceinline__ void p0_transpose_item(const float* W, int K, int N, bf16* WT, int k0, int n0, int drow0, LAS float* scr, int lane) {
    float wv[32];
#pragma unroll
    for (int i = 0; i < 32; ++i) { const int kk = 2 * i + (lane >> 5); wv[i] = W[(size_t)(k0 + kk) * N + n0 + (lane & 31)]; }
#pragma unroll
    for (int i = 0; i < 32; ++i) { const int kk = 2 * i + (lane >> 5); scr[kk * 33 + (lane & 31)] = wv[i]; }
    LDS_WAIT(); asm volatile("" ::: "memory");
    const int c = lane & 7;
#pragma unroll
    for (int j = 0; j < 4; ++j) { const int n = (lane >> 3) + 8 * j; const LAS float* s = scr + (8 * c) * 33 + n;
        v4u o; o.x = pk2(s[0 * 33], s[1 * 33]); o.y = pk2(s[2 * 33], s[3 * 33]); o.z = pk2(s[4 * 33], s[5 * 33]); o.w = pk2(s[6 * 33], s[7 * 33]);
        *(GAS v4u*)(WT + (size_t)(drow0 + n) * K + k0 + 8 * c) = o; }
    LDS_WAIT(); asm volatile("" ::: "memory");
}
__device__ __forceinline__ int up_row_map(int n) {
    const int g = n >= FF ? 1 : 0, c = n - g * FF;
    return (c >> 7) * 256 + g * 128 + (c & 127);
}
__device__ __forceinline__ void convert_layer_weights(Frame& F, const Args& A, int layer, int widx, int nw) {
    LAS float* scr = (LAS float*)(F.lds + F.wave * 8704);
    const int kind = layer % 3, j = layer / 3;
    const float* Win = kind == 0 ? A.in[12] + (size_t)j * D * 3104 : (kind == 1 ? A.in[17] : A.in[22]);
    const int Nin = kind == 2 ? 3072 : 3104;
    const float* Wout = kind == 0 ? A.in[16] + (size_t)j * D * D : (kind == 1 ? A.in[21] : A.in[24]);
    const float* Wup = A.in[8] + (size_t)layer * D * FF2;
    const float* Wdn = A.in[11] + (size_t)layer * FF * D;
    bf16* Tin = wb_ptr(F, layer, WB_IN); bf16* Tout = wb_ptr(F, layer, WB_OUT); bf16* Tup = wb_ptr(F, layer, WB_UP); bf16* Tdn = wb_ptr(F, layer, WB_DN);
    const int nb_in = Nin / 32, I_in = 16 * nb_in, I_out = 16 * 32, I_up = 16 * 176, I_dn = 44 * 32;
    const int NIT = I_in + I_out + I_up + I_dn;
    for (int it = widx; it < NIT; it += nw) {
        int r = it;
        if (r < I_in) { const int kb = r / nb_in, nb = r % nb_in; p0_transpose_item(Win, D, Nin, Tin, 64 * kb, 32 * nb, 32 * nb, scr, F.lane); continue; } r -= I_in;
        if (r < I_out) { const int kb = r / 32, nb = r % 32; p0_transpose_item(Wout, D, D, Tout, 64 * kb, 32 * nb, 32 * nb, scr, F.lane); continue; } r -= I_out;
        if (r < I_up) { const int kb = r / 176, nb = r % 176; p0_transpose_item(Wup, D, FF2, Tup, 64 * kb, 32 * nb, up_row_map(32 * nb), scr, F.lane); continue; } r -= I_up;
        { const int kb = r / 32, nb = r % 32; p0_transpose_item(Wdn, FF, D, Tdn, 64 * kb, 32 * nb, 32 * nb, scr, F.lane); }
    }
    if (kind != 2) {
        const int nz = (NINP - 3104) * D / 8;
        GAS v4u* z = (GAS v4u*)(Tin + (size_t)3104 * D);
        unsigned z_ = 0u; asm volatile("" : "+v"(z_));
        for (int i = widx * 64 + F.lane; i < nz; i += nw * 64) z[i] = (v4u){z_, z_, z_, z_};
    }
}
__device__ __forceinline__ void p0_adaln(Frame& F, const Args& A, int layer, int widx, int nw) {
    LAS float* sv = (LAS float*)(F.lds + 73728);
    LAS float* red = (LAS float*)(F.lds + 73728 + 36864);
    __syncthreads();
    for (int i = F.tid; i < 9 * D; i += NTHR) { const int r = i >> 10, k = i & 1023; const float c = r < 8 ? A.in[1][r * D + k] : A.in[3][k]; sv[i] = siluf_(c); }
    __syncthreads();
    const int col = F.lane & 31, kp = F.lane >> 5;
    for (int task = widx; task < 192; task += nw) {
        const int n0 = task * 32;
        const float* W = A.in[4] + (size_t)layer * D * 6144 + n0 + col;
        float acc[9];
#pragma unroll
        for (int r = 0; r < 9; ++r) acc[r] = 0.f;
        const int kbase = F.wave * 128 + kp;
#pragma unroll
        for (int ib = 0; ib < 2; ++ib) {
            float wv[32];
#pragma unroll
            for (int i = 0; i < 32; ++i) wv[i] = W[(size_t)(kbase + 2 * (ib * 32 + i)) * 6144];
#pragma unroll
            for (int i = 0; i < 32; ++i) { const int k = kbase + 2 * (ib * 32 + i);
#pragma unroll
                for (int r = 0; r < 9; ++r) acc[r] += sv[r * D + k] * wv[i]; }
        }
#pragma unroll
        for (int r = 0; r < 9; ++r) red[((F.wave * 2 + kp) * 9 + r) * 32 + col] = acc[r];
        __syncthreads();
        if (F.tid < 288) { const int r = F.tid >> 5, c2 = F.tid & 31; float s = 0.f;
#pragma unroll
            for (int p2 = 0; p2 < 16; ++p2) s += red[(p2 * 9 + r) * 32 + c2];
            F.MOD[((size_t)layer * 9 + r) * 6144 + n0 + c2] = s + A.in[5][layer * 6144 + n0 + c2]; }
        __syncthreads();
    }
}

__device__ __forceinline__ void norm_phase(Frame& F, const Args& A, int layer, int which, bool first, int nrows, const float* slab, const float* sgate) {
    const int gw = F.mi * NWAVES + F.wave, NGW = 32 * NWAVES, c0 = F.lane * 16;
    nrows = nrows == MT ? TL + TC : TL;
    const float* gam = (which == 0 ? A.in[6] : A.in[7]) + layer * D + c0;
    const float* mod = F.MOD + (size_t)layer * 9 * 6144 + (which == 0 ? 0 : 3072) + c0;
    float gv[16];
#pragma unroll
    for (int j = 0; j < 4; ++j) { const f32x4 g = *(const f32x4*)(gam + 4 * j); gv[4 * j] = g.x; gv[4 * j + 1] = g.y; gv[4 * j + 2] = g.z; gv[4 * j + 3] = g.w; }
    for (int rowA = gw; rowA < nrows; rowA += 2 * NGW) {
        const bool vB = rowA + NGW < nrows;
#pragma unroll
        for (int q = 0; q < 2; ++q) {
            if (q == 1 && !vB) break;
            const int row = grow(F, rowA + q * NGW);
            const int r = row < ML ? (row >> 11) : 8;
            float x[16];
            if (first) { const float* src = (row < ML ? A.in[0] + (size_t)row * D : A.in[2] + (size_t)(row - ML) * D) + c0;
#pragma unroll
                for (int j = 0; j < 4; ++j) { const f32x4 t = *(const f32x4*)(src + 4 * j); x[4 * j] = t.x; x[4 * j + 1] = t.y; x[4 * j + 2] = t.z; x[4 * j + 3] = t.w; }
            } else { const bf16* xr = F.X + (size_t)row * D + c0; unpk8(*(const v4u*)xr, x); unpk8(*(const v4u*)(xr + 8), x + 8); }
            const bool sl = slab != nullptr && row >= ML;
            if (sl) {
                const bf16* s16 = (const bf16*)slab + (size_t)(row - ML) * D + c0;
#pragma unroll
                for (int hv = 0; hv < 2; ++hv) { float p0[8], p1[8], p2[8], p3[8];
                    unpk8(*(const v4u*)(s16 + hv * 8), p0); unpk8(*(const v4u*)(s16 + (size_t)MC * D + hv * 8), p1); unpk8(*(const v4u*)(s16 + (size_t)2 * MC * D + hv * 8), p2); unpk8(*(const v4u*)(s16 + (size_t)3 * MC * D + hv * 8), p3);
                    const f32x4 sg0 = *(const f32x4*)(sgate + c0 + hv * 8), sg1 = *(const f32x4*)(sgate + c0 + hv * 8 + 4);
#pragma unroll
                    for (int i = 0; i < 8; ++i) x[hv * 8 + i] += (i < 4 ? sg0[i & 3] : sg1[i & 3]) * ((p0[i] + p1[i]) + (p2[i] + p3[i])); }
            }
            float s = 0.f;
#pragma unroll
            for (int i = 0; i < 16; ++i) s += x[i] * x[i];
            if (first || sl) { bf16* xw = F.X + (size_t)row * D + c0; *(v4u*)xw = pk8(x); *(v4u*)(xw + 8) = pk8(x + 8); }
            const float rinv = 1.0f / sqrtf(wave_sum(s) * (1.f / D) + EPS);
            const float* sh = mod + (size_t)r * 6144; const float* sc = sh + 1024;
            float y[16];
#pragma unroll
            for (int j = 0; j < 4; ++j) { const f32x4 a = *(const f32x4*)(sc + 4 * j), bb = *(const f32x4*)(sh + 4 * j);
                y[4 * j] = x[4 * j] * rinv * gv[4 * j] * (a.x + 1.0f) + bb.x; y[4 * j + 1] = x[4 * j + 1] * rinv * gv[4 * j + 1] * (a.y + 1.0f) + bb.y;
                y[4 * j + 2] = x[4 * j + 2] * rinv * gv[4 * j + 2] * (a.z + 1.0f) + bb.z; y[4 * j + 3] = x[4 * j + 3] * rinv * gv[4 * j + 3] * (a.w + 1.0f) + bb.w; }
            bf16* hw = F.H16 + (size_t)row * D + c0; *(v4u*)hw = pk8(y); *(v4u*)(hw + 8) = pk8(y + 8);
        }
    }
}
__device__ __forceinline__ void final_norm_phase(Frame& F, const Args& A) {
    const int gw = F.mi * NWAVES + F.wave, NGW = 32 * NWAVES, c0 = F.lane * 16;
    float gv[16];
#pragma unroll
    for (int j = 0; j < 4; ++j) { const f32x4 g = *(const f32x4*)(A.in[25] + c0 + 4 * j); gv[4 * j] = g.x; gv[4 * j + 1] = g.y; gv[4 * j + 2] = g.z; gv[4 * j + 3] = g.w; }
    for (int rowA = gw; rowA < TL; rowA += 2 * NGW) {
        const bool vB = rowA + NGW < TL;
        const bf16* xa = F.X + (size_t)(F.grp * TL + rowA) * D + c0; const bf16* xb = F.X + (size_t)(F.grp * TL + (vB ? rowA + NGW : rowA)) * D + c0;
        const v4u a0 = *(const v4u*)xa, a1 = *(const v4u*)(xa + 8), b0 = *(const v4u*)xb, b1 = *(const v4u*)(xb + 8);
#pragma unroll
        for (int q = 0; q < 2; ++q) {
            if (q == 1 && !vB) break;
            const int row = F.grp * TL + rowA + q * NGW;
            float x[16]; unpk8(q == 0 ? a0 : b0, x); unpk8(q == 0 ? a1 : b1, x + 8);
            float s = 0.f;
#pragma unroll
            for (int i = 0; i < 16; ++i) s += x[i] * x[i];
            const float rinv = 1.0f / sqrtf(wave_sum(s) * (1.f / D) + EPS);
#pragma unroll
            for (int j = 0; j < 4; ++j) *(f32x4*)(A.out + (size_t)row * D + c0 + 4 * j) = (f32x4){x[4 * j] * rinv * gv[4 * j], x[4 * j + 1] * rinv * gv[4 * j + 1], x[4 * j + 2] * rinv * gv[4 * j + 2], x[4 * j + 3] * rinv * gv[4 * j + 3]};
        }
    }
}

struct EpiInproj {
    static constexpr bool PERM = true, AFTER_DRAIN = false;
    bf16* P; float* G;
    __device__ __forceinline__ void operator()(const f32x4 (&acc)[2][2][4][2], const pg8::Unit& u, int wr, int wc, int fr, int fq) const {
        const int row0 = u.pm * 256 + wr * 64 + fr;
        if (u.pn < 12) {
            const int col0 = u.pn * 256 + wc * 32 + 8 * fq;
#pragma unroll
            for (int ai = 0; ai < 2; ++ai)
#pragma unroll
                for (int m = 0; m < 4; ++m) { bf16* rowp = P + (size_t)(row0 + ai * 128 + m * 16) * PLD + col0;
#pragma unroll
                    for (int bj = 0; bj < 2; ++bj) { const f32x4 v0 = acc[ai][bj][m][0], v1 = acc[ai][bj][m][1];
                        const v4u w = cvt8_st(v0[0], v0[1], v0[2], v0[3], v1[0], v1[1], v1[2], v1[3]);
                        *(v4u*)(rowp + bj * 128) = w; } }
        } else if (wc == 0) {
#pragma unroll
            for (int ai = 0; ai < 2; ++ai)
#pragma unroll
                for (int m = 0; m < 4; ++m) { float* rowp = G + (size_t)(row0 + ai * 128 + m * 16) * 32 + 8 * fq;
                    *(f32x4*)(rowp) = acc[ai][0][m][0]; *(f32x4*)(rowp + 4) = acc[ai][0][m][1]; }
        }
    }
};
struct EpiResid {
    static constexpr bool PERM = false, AFTER_DRAIN = false;
    float* X; const float* gate;
    __device__ __forceinline__ void operator()(const f32x4 (&acc)[2][2][4][2], const pg8::Unit& u, int wr, int wc, int fr, int fq) const {
        const int row0 = u.pm * 256 + wr * 64 + fr, col0 = u.pn * 256 + wc * 32 + 4 * fq;
        const int r = u.pm < 64 ? (u.pm >> 3) : 8;
        const float* gp = gate + (size_t)r * 6144 + col0;
        f32x4 gv[2][2];
#pragma unroll
        for (int bj = 0; bj < 2; ++bj)
#pragma unroll
            for (int n = 0; n < 2; ++n) gv[bj][n] = *(const f32x4*)(gp + bj * 128 + n * 16);
#pragma unroll
        for (int ai = 0; ai < 2; ++ai)
#pragma unroll
            for (int m = 0; m < 4; ++m) { float* rowp = X + (size_t)(row0 + ai * 128 + m * 16) * D + col0;
#pragma unroll
                for (int bj = 0; bj < 2; ++bj)
#pragma unroll
                    for (int n = 0; n < 2; ++n) { float* p = rowp + bj * 128 + n * 16; *(f32x4*)p = *(const f32x4*)p + gv[bj][n] * acc[ai][bj][m][n]; } }
    }
};
struct GroupOrder {
    int g, mi, npan, nN, ntK, wid;
    __device__ bool next(int i, pg8::Unit& u) const {
        const int L = i * 32 + mi; if (L >= npan * nN) return false;
        const int pcol = L / npan, p = L - pcol * npan;
        u.pm = p < 8 ? g * 8 + p : 64 + g; u.pn = pcol; u.k0 = 0; u.nt = ntK; return true;
    }
    __device__ __forceinline__ void a_ready(const pg8::Unit&) const {}
    __device__ __forceinline__ void done(const pg8::Unit&) const {}
};
struct GroupSplitOrder {
    int g, mi, ntK, np, wid;
    __device__ bool next(int i, pg8::Unit& u) const {
        const bool piece = mi < np;
        if (piece && i == 0) { const int q = mi & 3; u.pm = 64 + g; u.pn = mi >> 2;
            if (ntK == 16) { u.k0 = q * 256; u.nt = 4; } else { u.k0 = (q < 2 ? q * 10 : 20 + (q - 2) * 12) * 64; u.nt = q < 2 ? 10 : 12; }
            return true; }
        if (i == (piece ? 1 : 0)) { u.pm = g * 8 + (mi & 7); u.pn = mi >> 3; u.k0 = 0; u.nt = ntK; return true; }
        return false;
    }
    __device__ __forceinline__ void a_ready(const pg8::Unit&) const {}
    __device__ __forceinline__ void done(const pg8::Unit&) const {}
};
struct SplitOrder {
    pg8::StaticOrder lat; int G, c, ntK, np, wid;
    __device__ void init(int K, int G_, int c_, bool with_ctx) { lat.init(ML, D, G_, c_); lat.ntK = K / 64; G = G_; c = c_; ntK = K / 64; np = with_ctx ? 128 : 0; }
    __device__ bool next(int i, pg8::Unit& u) const {
        if (G == 256) {
            if (c < np) { if (i == 0) {   } else if (i == 1) return lat.next(0, u); else return false; }
            else return i == 0 ? lat.next(0, u) : false;
        }
        const int L = G == 256 ? 256 + c : i * G + c;
        if (L < 256) return lat.next(i, u);
        const int piece = L - 256; if (piece >= np) return false;
        const int unit = piece >> 2, q = piece & 3;
        u.pm = 64 + (unit >> 2); u.pn = unit & 3;
        if (ntK == 16) { u.k0 = q * 256; u.nt = 4; }
        else { u.k0 = (q < 2 ? q * 10 : 20 + (q - 2) * 12) * 64; u.nt = q < 2 ? 10 : 12; }
        return true;
    }
    __device__ __forceinline__ void a_ready(const pg8::Unit&) const {}
    __device__ __forceinline__ void done(const pg8::Unit&) const {}
};
struct EpiResidSplit {
    static constexpr bool PERM = true, AFTER_DRAIN = false;
    bf16* X; const float* gate; float* SLAB; int dry;
    __device__ __forceinline__ void operator()(const f32x4 (&acc)[2][2][4][2], const pg8::Unit& u, int wr, int wc, int fr, int fq) const {
        const int row0 = u.pm * 256 + wr * 64 + fr, col0 = u.pn * 256 + wc * 32 + 8 * fq;
        if (u.pm < 64) {
            if (dry) return;
            const float* gp = gate + (size_t)(u.pm >> 3) * 6144 + col0;
            f32x4 g0[2], g1[2];
#pragma unroll
            for (int bj = 0; bj < 2; ++bj) { g0[bj] = *(const f32x4*)(gp + bj * 128); g1[bj] = *(const f32x4*)(gp + bj * 128 + 4); }
#pragma unroll
            for (int ai = 0; ai < 2; ++ai)
#pragma unroll
                for (int m = 0; m < 4; ++m) { bf16* rowp = X + (size_t)(row0 + ai * 128 + m * 16) * D + col0;
#pragma unroll
                    for (int bj = 0; bj < 2; ++bj) { bf16* pp = rowp + bj * 128; const v4u xo = *(const v4u*)pp;
                        const f32x4 x0 = (f32x4){bflo(xo.x), bfhi(xo.x), bflo(xo.y), bfhi(xo.y)} + g0[bj] * acc[ai][bj][m][0];
                        const f32x4 x1 = (f32x4){bflo(xo.z), bfhi(xo.z), bflo(xo.w), bfhi(xo.w)} + g1[bj] * acc[ai][bj][m][1];
                        const v4u w = cvt8_st(x0[0], x0[1], x0[2], x0[3], x1[0], x1[1], x1[2], x1[3]);
                        *(v4u*)pp = w; } }
        } else {
            const int q = u.nt == 4 ? (u.k0 >> 8) : (u.k0 < 1280 ? u.k0 / 640 : 2 + (u.k0 - 1280) / 768);
            bf16* sb = (bf16*)SLAB + (size_t)q * MC * D;
#pragma unroll
            for (int ai = 0; ai < 2; ++ai)
#pragma unroll
                for (int m = 0; m < 4; ++m) { bf16* rowp = sb + (size_t)(row0 - ML + ai * 128 + m * 16) * D + col0;
#pragma unroll
                    for (int bj = 0; bj < 2; ++bj) { const f32x4 v0 = acc[ai][bj][m][0], v1 = acc[ai][bj][m][1];
                        const v4u w = cvt8_st(v0[0], v0[1], v0[2], v0[3], v1[0], v1[1], v1[2], v1[3]);
                        *(v4u*)(rowp + bj * 128) = w; } }
        }
    }
};
struct EpiConvGate {
    static constexpr bool PERM = false, AFTER_DRAIN = false;
    bf16* ACT; float* EDGE; const float* cw; const float* cb; LAS float* ce;
    __device__ __forceinline__ void operator()(const f32x4 (&acc)[2][2][4][2], const pg8::Unit& u, int wr, int wc, int fr, int fq) const {
        const int lane = fq * 16 + fr;
        float pw[2][8];
#pragma unroll
        for (int n = 0; n < 2; ++n) { const int c = u.pn * 128 + wc * 32 + n * 16 + fr;
            pw[n][0] = cw[c]; pw[n][1] = cw[FF2 + c]; pw[n][2] = cw[2 * FF2 + c]; pw[n][3] = cb[c];
            pw[n][4] = cw[FF + c]; pw[n][5] = cw[FF2 + FF + c]; pw[n][6] = cw[2 * FF2 + FF + c]; pw[n][7] = cb[FF + c]; }
#pragma unroll
        for (int ai = 0; ai < 2; ++ai) { const int blk = ai * 2 + wr;
#pragma unroll
            for (int bj = 0; bj < 2; ++bj)
#pragma unroll
                for (int n = 0; n < 2; ++n) { const int col = bj * 128 + wc * 32 + n * 16 + fr;
                    if (fq == 0) ce[(blk * 2 + 0) * 256 + col] = acc[ai][bj][0][n][0];
                    if (fq == 3) ce[(blk * 2 + 1) * 256 + col] = acc[ai][bj][3][n][3]; } }
        {
            float* eb = EDGE + (size_t)u.pm * 4 * FF2 + u.pn * 256;
#pragma unroll
            for (int bj = 0; bj < 2; ++bj)
#pragma unroll
                for (int n = 0; n < 2; ++n) { const int col = bj * 128 + wc * 32 + n * 16 + fr;
                    if (wr == 0 && fq == 0) { eb[0 * FF2 + col] = acc[0][bj][0][n][0]; eb[1 * FF2 + col] = acc[0][bj][0][n][1]; }
                    if (wr == 1 && fq == 3) { eb[2 * FF2 + col] = acc[1][bj][3][n][2]; eb[3 * FF2 + col] = acc[1][bj][3][n][3]; } }
        }
        asm volatile("s_waitcnt lgkmcnt(0)" ::: "memory"); __builtin_amdgcn_s_barrier(); asm volatile("" ::: "memory");
        const int upl = (lane + 48) & 63, dnl = (lane + 16) & 63;
        bf16* tb = ACT + (size_t)u.pm * 256 * FF + u.pn * 128;
        bf16* tb1 = tb + FF; bf16* tb2 = tb + 2 * FF; bf16* tb3 = tb + 3 * FF;
#pragma unroll
        for (int n = 0; n < 2; ++n) {
            const int c = u.pn * 128 + wc * 32 + n * 16 + fr;
            const float kg = -1.4426950408889634f, ka = -0.6931471805599453f;
            const float wa0 = pw[n][0] * ka, wa1 = pw[n][1] * ka, wa2 = pw[n][2] * ka, ba = pw[n][3] * ka;
            const float wg0 = pw[n][4] * kg, wg1 = pw[n][5] * kg, wg2 = pw[n][6] * kg, bg = pw[n][7] * kg;
#pragma unroll
            for (int ai = 0; ai < 2; ++ai) {
                const int blk = ai * 2 + wr;
                const int cola = wc * 32 + n * 16 + fr, colg = 128 + cola;
                const float epa = blk > 0 ? ce[((blk - 1) * 2 + 1) * 256 + cola] : 0.f, epg = blk > 0 ? ce[((blk - 1) * 2 + 1) * 256 + colg] : 0.f;
                const float ena = blk < 3 ? ce[((blk + 1) * 2 + 0) * 256 + cola] : 0.f, eng = blk < 3 ? ce[((blk + 1) * 2 + 0) * 256 + colg] : 0.f;
                float sUa[4], sDa[4], sUg[4], sDg[4];
#pragma unroll
                for (int m = 0; m < 4; ++m) { sUa[m] = __shfl(acc[ai][0][m][n][3], upl); sDa[m] = __shfl(acc[ai][0][m][n][0], dnl);
                                              sUg[m] = __shfl(acc[ai][1][m][n][3], upl); sDg[m] = __shfl(acc[ai][1][m][n][0], dnl); }
#pragma unroll
                for (int m = 0; m < 4; ++m) {
                    const f32x4 xa = acc[ai][0][m][n], xg = acc[ai][1][m][n];
                    const float pa = fq > 0 ? sUa[m] : (m > 0 ? sUa[m > 0 ? m - 1 : 0] : epa), pg = fq > 0 ? sUg[m] : (m > 0 ? sUg[m > 0 ? m - 1 : 0] : epg);
                    const float na = fq < 3 ? sDa[m] : (m < 3 ? sDa[m < 3 ? m + 1 : 3] : ena), ng = fq < 3 ? sDg[m] : (m < 3 ? sDg[m < 3 ? m + 1 : 3] : eng);
                    const float a0 = fmaf(wa0, pa,    fmaf(wa1, xa[0], fmaf(wa2, xa[1], ba))), g0 = fmaf(wg0, pg,    fmaf(wg1, xg[0], fmaf(wg2, xg[1], bg)));
                    const float a1 = fmaf(wa0, xa[0], fmaf(wa1, xa[1], fmaf(wa2, xa[2], ba))), g1 = fmaf(wg0, xg[0], fmaf(wg1, xg[1], fmaf(wg2, xg[2], bg)));
                    const float a2 = fmaf(wa0, xa[1], fmaf(wa1, xa[2], fmaf(wa2, xa[3], ba))), g2 = fmaf(wg0, xg[1], fmaf(wg1, xg[2], fmaf(wg2, xg[3], bg)));
                    const float a3 = fmaf(wa0, xa[2], fmaf(wa1, xa[3], fmaf(wa2, na,    ba))), g3 = fmaf(wg0, xg[2], fmaf(wg1, xg[3], fmaf(wg2, ng,    bg)));
                    const float y0 = (a0 * g0) * __builtin_amdgcn_rcpf(1.0f + __builtin_amdgcn_exp2f(g0)), y1 = (a1 * g1) * __builtin_amdgcn_rcpf(1.0f + __builtin_amdgcn_exp2f(g1));
                    const float y2 = (a2 * g2) * __builtin_amdgcn_rcpf(1.0f + __builtin_amdgcn_exp2f(g2)), y3 = (a3 * g3) * __builtin_amdgcn_rcpf(1.0f + __builtin_amdgcn_exp2f(g3));
                    const unsigned ob = ((unsigned)(ai * 128 + wr * 64 + m * 16 + 4 * fq) * FF + (unsigned)(wc * 32 + n * 16 + fr)) * 2u;
                    const unsigned p01 = cvtpk(y0, y1), p23 = cvtpk(y2, y3);
                    asm volatile("global_store_short %0, %1, %2" :: "v"(ob), "v"(p01), "s"(tb) : "memory");
                    asm volatile("global_store_short_d16_hi %0, %1, %2" :: "v"(ob), "v"(p01), "s"(tb1) : "memory");
                    asm volatile("global_store_short %0, %1, %2" :: "v"(ob), "v"(p23), "s"(tb2) : "memory");
                    asm volatile("global_store_short_d16_hi %0, %1, %2" :: "v"(ob), "v"(p23), "s"(tb3) : "memory");
                }
            }
        }
        asm volatile("s_waitcnt lgkmcnt(0)" ::: "memory"); __builtin_amdgcn_s_barrier(); asm volatile("" ::: "memory");
    }
};
__device__ __forceinline__ void ffn_fixup_phase(Frame& F, const Args& A, int layer) {
    bf16* ACT = F.P16;
    const float* cw = A.in[9] + (size_t)layer * 3 * FF2; const float* cb = A.in[10] + (size_t)layer * FF2;
    for (int task = 14 * F.grp + F.mi; task < 14 * F.grp + 14; task += 32) {
        const int bnd = task >> 1, lower = task & 1;
        const int pmA = (bnd / 7) * 8 + (bnd % 7);
        const float* eA = F.EDGE + (size_t)pmA * 4 * FF2; const float* eB = eA + 4 * FF2;
        const float* rp = lower ? eA + 3 * FF2 : eA + 2 * FF2;
        const float* rc = lower ? eB + 0 * FF2 : eA + 3 * FF2;
        const float* rn = lower ? eB + 1 * FF2 : eB + 0 * FF2;
        const int row = lower ? (pmA + 1) * 256 : pmA * 256 + 255;
        for (int c = F.tid; c < FF; c += NTHR) {
            const int ea = (c >> 7) * 256 + (c & 127), eg = ea + 128;
            const float a = cw[c] * rp[ea] + cw[FF2 + c] * rc[ea] + cw[2 * FF2 + c] * rn[ea] + cb[c];
            const float g = cw[FF + c] * rp[eg] + cw[FF2 + FF + c] * rc[eg] + cw[2 * FF2 + FF + c] * rn[eg] + cb[FF + c];
            ACT[(size_t)row * FF + c] = (bf16)f2bf(a * siluf_(g));
        }
    }
}

#define MFMA16(a, b, c) __builtin_amdgcn_mfma_f32_16x16x32_bf16((a), (b), (c), 0, 0, 0)
__device__ __forceinline__ bf16x8 cvt8_mma(float a0, float a1, float a2, float a3, float a4, float a5, float a6, float a7) {
    v4u p;
    asm volatile("s_nop 0\n\tv_cvt_pk_bf16_f32 %0, %4, %5\n\tv_cvt_pk_bf16_f32 %1, %6, %7\n\tv_cvt_pk_bf16_f32 %2, %8, %9\n\tv_cvt_pk_bf16_f32 %3, %10, %11\n\ts_nop 1"
                 : "=&v"(p.x), "=&v"(p.y), "=&v"(p.z), "=&v"(p.w) : "v"(a0), "v"(a1), "v"(a2), "v"(a3), "v"(a4), "v"(a5), "v"(a6), "v"(a7));
    return __builtin_bit_cast(bf16x8, p);
}
#define PIN2(a, b) asm volatile("" : "+v"(a), "+v"(b))
#define PIN4(a, b, c, d) asm volatile("" : "+v"(a), "+v"(b), "+v"(c), "+v"(d))
#define PIN5(a, b, c, d, e) asm volatile("" : "+v"(a), "+v"(b), "+v"(c), "+v"(d), "+v"(e))
#define PIN8(a, b, c, d, e, f, g, h) asm volatile("" : "+v"(a), "+v"(b), "+v"(c), "+v"(d), "+v"(e), "+v"(f), "+v"(g), "+v"(h))
__device__ __forceinline__ bf16x8 ldfrag(const LAS bf16* base, int ld, int r0, int k0, int lane) {
    return *(const LAS bf16x8*)(base + (r0 + (lane & 15)) * ld + k0 + 8 * (lane >> 4));
}
__device__ __forceinline__ void unpack8(const v4u w, float* f) {
    f[0] = bflo(w.x); f[1] = bfhi(w.x); f[2] = bflo(w.y); f[3] = bfhi(w.y); f[4] = bflo(w.z); f[5] = bfhi(w.z); f[6] = bflo(w.w); f[7] = bfhi(w.w);
}
__device__ __forceinline__ v4u pack8(const float* f) { v4u w; w.x = pk2(f[0], f[1]); w.y = pk2(f[2], f[3]); w.z = pk2(f[4], f[5]); w.w = pk2(f[6], f[7]); return w; }

typedef short s16x4 __attribute__((ext_vector_type(4)));
__device__ __forceinline__ bf16x8 ldfrag_tr(const LAS bf16* base, int ld, int k0, int c0, int lane) {
    const int i = lane & 15, kq = lane >> 4;
    const LAS bf16* p = base + (k0 + 8 * kq + (i >> 2)) * ld + c0 + 4 * (i & 3);
    const s16x4 lo = __builtin_amdgcn_ds_read_tr16_b64_v4i16((LAS s16x4*)p);
    const s16x4 hi = __builtin_amdgcn_ds_read_tr16_b64_v4i16((LAS s16x4*)(p + 4 * ld));
    return (bf16x8){lo.x, lo.y, lo.z, lo.w, hi.x, hi.y, hi.z, hi.w};
}
__device__ __forceinline__ bf16x8 ldfrag_tr4(const LAS bf16* base, int ld, int s0, int c0, int lane) {
    const int i = lane & 15, kq = lane >> 4;
    const LAS bf16* p = base + (s0 + 4 * kq + (i >> 2)) * ld + c0 + 4 * (i & 3);
    const s16x4 lo = __builtin_amdgcn_ds_read_tr16_b64_v4i16((LAS s16x4*)p);
    const s16x4 hi = __builtin_amdgcn_ds_read_tr16_b64_v4i16((LAS s16x4*)(p + 16 * ld));
    return (bf16x8){lo.x, lo.y, lo.z, lo.w, hi.x, hi.y, hi.z, hi.w};
}
__device__ __forceinline__ void mlstm_prep_phase(Frame& F, const Args& A, int jk, bf16* QKl, bf16* QKc) {
    const float* convw = A.in[14] + (size_t)jk * 3 * 1024; const float* convb = A.in[15] + (size_t)jk * 1024;
    const int gw = F.mi * NWAVES + F.wave, NGW = 32 * NWAVES, lane = F.lane;
    for (int task = gw; task < 576; task += NGW) {
        const int half = task & 1, row0 = grow(F, (task >> 1) * 8);
        const bool lat = row0 < ML;
        const int tpos = lat ? (row0 & (TL - 1)) : ((row0 - ML) & (TC - 1)), Tn = lat ? TL : TC;
        const int c0 = half * 512 + lane * 8;
        float w0[8], w1[8], w2[8], bb[8];
#pragma unroll
        for (int i = 0; i < 8; ++i) { w0[i] = convw[c0 + i]; w1[i] = convw[1024 + c0 + i]; w2[i] = convw[2048 + c0 + i]; bb[i] = convb[c0 + i]; }
        const float sc = half == 0 ? 0.125f : 1.0f;
        const bf16* src = F.P16 + (size_t)row0 * PLD + c0;
        bf16* dst = (lat ? QKl + (size_t)row0 * D : QKc + (size_t)(row0 - ML) * D) + c0;
        v4u xr[10];
#pragma unroll
        for (int i = 0; i < 10; ++i) { const int tp = tpos - 1 + i; xr[i] = (tp >= 0 && tp < Tn) ? *(const v4u*)(src + (ptrdiff_t)(i - 1) * PLD) : (v4u){0u, 0u, 0u, 0u}; }
#pragma unroll
        for (int t = 0; t < 8; ++t) {
            float xp[8], xc[8], xn[8], y[8];
            unpack8(xr[t], xp); unpack8(xr[t + 1], xc); unpack8(xr[t + 2], xn);
#pragma unroll
            for (int i = 0; i < 8; ++i) y[i] = siluf_(w0[i] * xp[i] + w1[i] * xc[i] + w2[i] * xn[i] + bb[i]) * sc;
            *(v4u*)(dst + (size_t)t * D) = pack8(y);
        }
    }
}
__device__ __forceinline__ void mlstm_phase(Frame& F, const Args& A, int jk, const bf16* QKl, const bf16* QKc, f32x4* GJ) {
    LAS float* ga = (LAS float*)(F.lds + 57344);
    LAS float* aa = (LAS float*)(F.lds + 57344 + 9216);
    LAS float* cma = (LAS float*)(F.lds + 57344 + 18432);
    LAS float* scl = (LAS float*)(F.lds + 137728);
    const float* bgate = A.in[13] + jk * 32;
    const int tid = F.tid, lane = F.lane, wave = F.wave, fr = lane & 15, fq = lane >> 4;
    for (int task = F.vcu; task < 256; task += F.G) {
        const int eh = task & 1, dir = (task >> 1) & 1, h = (task >> 2) & 7, b = task >> 5;
        const int e0 = eh * 64;
        bf16* Hout = dir == 0 ? F.H16 : F.HB16;
        f32x4* gj = GJ + (size_t)task * 2304;
        __syncthreads();
        for (int i = tid; i < 80 * 72 / 2; i += NTHR) ((LAS unsigned*)(F.lds + 114688))[i] = 0u;
        if (tid < 256) { unsigned z_ = 0u; asm volatile("" : "+v"(z_));
            LAS v4u* p = (LAS v4u*)(F.lds + (tid >> 7) * 57344 + 36864 + ((tid & 127) * 80 + 64) * 2); p[0] = (v4u){0x3F80u | z_, z_, z_, z_}; p[1] = (v4u){z_, z_, z_, z_}; }
        {
            const float bi = bgate[(2 * dir) * 8 + h], bfg = bgate[(2 * dir + 1) * 8 + h];
            for (int c = wave; c < 18; c += 8) {
                const bool isctx = c < 2; const int cc = isctx ? c : c - 2; const int Tn = isctx ? TC : TL;
                const int rowbase = isctx ? ML + b * TC : b * TL;
                const int t0 = dir == 0 ? cc * 128 : Tn - 128 * (cc + 1);
                const int j0 = 2 * lane, p0 = dir == 0 ? t0 + j0 : t0 + 127 - j0, p1 = dir == 0 ? p0 + 1 : p0 - 1;
                const float* g0p = F.G32 + (size_t)(rowbase + p0) * 32; const float* g1p = F.G32 + (size_t)(rowbase + p1) * 32;
                const float ig0 = g0p[(2 * dir) * 8 + h] + bi, lf0 = logsigmoidf_(g0p[(2 * dir + 1) * 8 + h] + bfg);
                const float ig1 = g1p[(2 * dir) * 8 + h] + bi, lf1 = logsigmoidf_(g1p[(2 * dir + 1) * 8 + h] + bfg);
                float sum = lf0 + lf1;
#pragma unroll
                for (int o = 1; o < 64; o <<= 1) { const float t = __shfl_up(sum, o); if (lane >= o) sum += t; }
                const float gg0 = sum - lf1, gg1 = sum;
                const float a0 = ig0 - gg0, a1 = ig1 - gg1;
                float mx = fmaxf(a0, a1);
#pragma unroll
                for (int o = 1; o < 64; o <<= 1) { const float t = __shfl_up(mx, o); if (lane >= o) mx = fmaxf(mx, t); }
                float ex = __shfl_up(mx, 1); if (lane == 0) ex = -INFINITY;
                const float c0v = fmaxf(ex, a0), c1v = mx;
                ga[c * 128 + j0] = gg0; ga[c * 128 + j0 + 1] = gg1; aa[c * 128 + j0] = a0; aa[c * 128 + j0 + 1] = a1; cma[c * 128 + j0] = c0v; cma[c * 128 + j0 + 1] = c1v;
                if (lane == 63) { scl[c] = gg1; scl[32 + c] = c1v; }
            }
        }
        __syncthreads();
        if (tid == 0) { float m = 0.f;
            for (int c = 0; c < 18; ++c) { const float gL = scl[c], cmL = scl[32 + c], mn = gL + fmaxf(m, cmL); scl[64 + c] = m; scl[96 + c] = __expf(gL + m - mn); scl[128 + c] = __expf(gL + cmL - mn); m = mn; } }
        __syncthreads();
        for (int idx = tid; idx < 2304; idx += NTHR) { const int c = idx >> 7; const float mc = scl[64 + c], cmL = scl[32 + c], mxj = fmaxf(cma[idx], mc);
            gj[idx] = (f32x4){__expf(aa[idx] - cmL), __expf(cmL - mxj), __expf(mc - mxj), __expf(-(ga[idx] + mxj))}; }
        asm volatile("s_waitcnt vmcnt(0)" ::: "memory");
        __syncthreads();
        f32x4 st[5];
#pragma unroll
        for (int k = 0; k < 5; ++k) st[k] = (f32x4){0.f, 0.f, 0.f, 0.f};
        const int nst = wave < 2 ? 5 : (wave < 4 ? 3 : (wave < 6 ? 2 : 0));
        const int st0i = wave < 2 ? wave * 5 : (wave < 4 ? 10 + (wave - 2) * 3 : 16 + (wave - 4) * 2);
        const int s = tid >> 2, cg = tid & 3, jt = wave;
        v4u rq0, rq1, rk0, rk1, rv0, rv1; float e1n; f32x4 jn;
#define MLSTM_LOAD(stepn) do { const bool ic_ = (stepn) < 2; const int c_ = ic_ ? (stepn) : (stepn) - 2, Tn_ = ic_ ? TC : TL; \
            const int t0_ = dir == 0 ? c_ * 128 : Tn_ - 128 * (c_ + 1), pos_ = dir == 0 ? t0_ + s : t0_ + 127 - s; \
            const bf16* qk_ = ic_ ? QKc + (size_t)(b * TC + pos_) * D : QKl + (size_t)(b * TL + pos_) * D; \
            const bf16* pv_ = F.P16 + (size_t)((ic_ ? ML + b * TC : b * TL) + pos_) * PLD + 1024 + h * 128 + e0 + cg * 16; \
            rq0 = *(const v4u*)(qk_ + h * 64 + cg * 16); rq1 = *(const v4u*)(qk_ + h * 64 + cg * 16 + 8); \
            rk0 = *(const v4u*)(qk_ + 512 + h * 64 + cg * 16); rk1 = *(const v4u*)(qk_ + 512 + h * 64 + cg * 16 + 8); \
            rv0 = *(const v4u*)(pv_); rv1 = *(const v4u*)(pv_ + 8); \
            e1n = ((const float*)(gj + (stepn) * 128 + s))[0]; jn = gj[(stepn) * 128 + 16 * jt + fr]; } while (0)
        MLSTM_LOAD(0);
        for (int step = 0; step < 18; ++step) {
            const int p = step & 1;
            LAS bf16* Qs = (LAS bf16*)(F.lds + p * 57344);
            LAS bf16* Kw = (LAS bf16*)(F.lds + p * 57344 + 18432);
            LAS bf16* Vs = (LAS bf16*)(F.lds + p * 57344 + 36864);
            const LAS bf16* CTr = (const LAS bf16*)(F.lds + 114688 + p * 11520);
            LAS bf16* CTw = (LAS bf16*)(F.lds + 114688 + (p ^ 1) * 11520);
            const bool isctx = step < 2; const int c = isctx ? step : step - 2; const int Tn = isctx ? TC : TL;
            const int rowbase = isctx ? ML + b * TC : b * TL;
            const int t0 = dir == 0 ? c * 128 : Tn - 128 * (c + 1);
            {
                *(LAS v4u*)(Qs + s * 72 + cg * 16) = rq0; *(LAS v4u*)(Qs + s * 72 + cg * 16 + 8) = rq1;
                float kf[16]; unpack8(rk0, kf); unpack8(rk1, kf + 8);
#pragma unroll
                for (int i = 0; i < 16; ++i) kf[i] *= e1n;
                v4u w0, w1; w0.x = pg8::cvt_pk_bf16(kf[0], kf[1]); w0.y = pg8::cvt_pk_bf16(kf[2], kf[3]); w0.z = pg8::cvt_pk_bf16(kf[4], kf[5]); w0.w = pg8::cvt_pk_bf16(kf[6], kf[7]);
                w1.x = pg8::cvt_pk_bf16(kf[8], kf[9]); w1.y = pg8::cvt_pk_bf16(kf[10], kf[11]); w1.z = pg8::cvt_pk_bf16(kf[12], kf[13]); w1.w = pg8::cvt_pk_bf16(kf[14], kf[15]);
                *(LAS v4u*)(Kw + s * 72 + cg * 16) = w0; *(LAS v4u*)(Kw + s * 72 + cg * 16 + 8) = w1;
                *(LAS v4u*)(Vs + s * 80 + cg * 16) = rv0; *(LAS v4u*)(Vs + s * 80 + cg * 16 + 8) = rv1;
            }
            const float e2 = jn.y, itr = jn.z, enm = jn.w;
            if (step + 1 < 18) MLSTM_LOAD(step + 1);
            asm volatile("s_waitcnt lgkmcnt(0)" ::: "memory"); __builtin_amdgcn_s_barrier(); asm volatile("" ::: "memory");
            {
                bf16x8 qb0 = ldfrag(Qs, 72, 16 * jt, 0, lane), qb1 = ldfrag(Qs, 72, 16 * jt, 32, lane);
                f32x4 nT[5];
#pragma unroll
                for (int et = 0; et < 5; ++et) nT[et] = (f32x4){0.f, 0.f, 0.f, 0.f};
                for (int sp = 0; sp <= (jt >> 1); ++sp) {
                    const int ts0 = 2 * sp, ts1 = 2 * sp + 1;
                    bf16x8 k0a = ldfrag(Kw, 72, 16 * ts0, 0, lane), k0b = ldfrag(Kw, 72, 16 * ts0, 32, lane), k1a = ldfrag(Kw, 72, 16 * ts1, 0, lane), k1b = ldfrag(Kw, 72, 16 * ts1, 32, lane);
                    bf16x8 vf[5];
#pragma unroll
                    for (int et = 0; et < 5; ++et) vf[et] = ldfrag_tr4(Vs, 80, 32 * sp, 16 * et, lane);
                    PIN2(qb0, qb1); PIN4(k0a, k0b, k1a, k1b); PIN5(vf[0], vf[1], vf[2], vf[3], vf[4]);
                    f32x4 sT0 = {0.f, 0.f, 0.f, 0.f}, sT1 = sT0, sT2 = sT0, sT3 = sT0;
                    sT0 = MFMA16(k0a, qb0, sT0); sT1 = MFMA16(k1a, qb0, sT1); sT2 = MFMA16(k0b, qb1, sT2); sT3 = MFMA16(k1b, qb1, sT3);
                    sT0 = sT0 + sT2; sT1 = sT1 + sT3;
#pragma unroll
                    for (int reg = 0; reg < 4; ++reg) { const bool v0 = (ts0 < jt) || (4 * fq + reg <= fr), v1 = (ts1 < jt) || (ts1 == jt && 4 * fq + reg <= fr);
                        sT0[reg] = v0 ? sT0[reg] : 0.f; sT1[reg] = v1 ? sT1[reg] : 0.f; }
                    const bf16x8 pf = cvt8_mma(sT0[0], sT0[1], sT0[2], sT0[3], sT1[0], sT1[1], sT1[2], sT1[3]);
#pragma unroll
                    for (int et = 0; et < 5; ++et) nT[et] = MFMA16(vf[et], pf, nT[et]);
                }
                {
                    bf16x8 cf[10];
#pragma unroll
                    for (int et = 0; et < 5; ++et) { cf[2 * et] = ldfrag(CTr, 72, 16 * et, 0, lane); cf[2 * et + 1] = ldfrag(CTr, 72, 16 * et, 32, lane); }
                    PIN5(cf[0], cf[1], cf[2], cf[3], cf[4]); PIN5(cf[5], cf[6], cf[7], cf[8], cf[9]);
                    f32x4 qc[5], qd[5];
#pragma unroll
                    for (int et = 0; et < 5; ++et) { qc[et] = (f32x4){0.f, 0.f, 0.f, 0.f}; qc[et] = MFMA16(cf[2 * et], qb0, qc[et]); }
#pragma unroll
                    for (int et = 0; et < 5; ++et) { qd[et] = (f32x4){0.f, 0.f, 0.f, 0.f}; qd[et] = MFMA16(cf[2 * et + 1], qb1, qd[et]); }
#pragma unroll
                    for (int et = 0; et < 5; ++et) nT[et] = nT[et] * e2 + (qc[et] + qd[et]) * itr;
                }
                const float den = __shfl(nT[4][0], fr);
                const float inv = 1.0f / fmaxf(fabsf(den), enm);
                const int jj = 16 * jt + fr; const int pos = dir == 0 ? t0 + jj : t0 + 127 - jj;
                bf16* op = Hout + (size_t)(rowbase + pos) * D + h * 128 + e0 + 4 * fq;
#pragma unroll
                for (int et = 0; et < 4; ++et) { v2u w; w.x = pg8::cvt_pk_bf16(nT[et][0] * inv, nT[et][1] * inv); w.y = pg8::cvt_pk_bf16(nT[et][2] * inv, nT[et][3] * inv); *(v2u*)(op + 16 * et) = w; }
            }
            {
                const float decay = scl[96 + step], sc2 = scl[128 + step];
#pragma unroll
                for (int k = 0; k < 5; ++k) {
                    if (k < nst) { const int ti = st0i + k, et = ti >> 2, dt = ti & 3;
                        bf16x8 va[4], kb[4];
#pragma unroll
                        for (int ks = 0; ks < 4; ++ks) { va[ks] = ldfrag_tr(Vs, 80, 32 * ks, 16 * et, lane); kb[ks] = ldfrag_tr(Kw, 72, 32 * ks, 16 * dt, lane); }
                        PIN4(va[0], va[1], va[2], va[3]); PIN4(kb[0], kb[1], kb[2], kb[3]);
                        f32x4 t0a = {0.f, 0.f, 0.f, 0.f}, t1a = t0a;
                        t0a = MFMA16(va[0], kb[0], t0a); t1a = MFMA16(va[1], kb[1], t1a); t0a = MFMA16(va[2], kb[2], t0a); t1a = MFMA16(va[3], kb[3], t1a);
                        st[k] = st[k] * decay + (t0a + t1a) * sc2; }
                }
#pragma unroll
                for (int k = 0; k < 5; ++k) {
                    if (k < nst) { const int ti = st0i + k, et = ti >> 2, dt = ti & 3;
#pragma unroll
                        for (int reg = 0; reg < 4; ++reg) CTw[(16 * et + 4 * fq + reg) * 72 + 16 * dt + fr] = (bf16)f2bf(st[k][reg]); }
                }
            }
        }
#undef MLSTM_LOAD
    }
}
__device__ __forceinline__ void mlstm_combine_phase(Frame& F, const Args& A, int nrows) {
    const int gw = F.mi * NWAVES + F.wave, NGW = 32 * NWAVES, nloc = nrows == MT ? TL + TC : TL;
    for (int lr = gw; lr < nloc; lr += NGW) { const int row = grow(F, lr);
        bf16* hf = F.H16 + (size_t)row * D + F.lane * 16; const bf16* hb = F.HB16 + (size_t)row * D + F.lane * 16; const bf16* o = F.P16 + (size_t)row * PLD + 2048 + F.lane * 16;
#pragma unroll
        for (int hv = 0; hv < 2; ++hv) { float a[8], b2[8], g[8], y[8];
            unpack8(*(const v4u*)(hf + hv * 8), a); unpack8(*(const v4u*)(hb + hv * 8), b2); unpack8(*(const v4u*)(o + hv * 8), g);
#pragma unroll
            for (int i = 0; i < 8; ++i) y[i] = (a[i] + b2[i]) * sigmoidf_(g[i]);
            *(v4u*)(hf + hv * 8) = pack8(y); }
    }
}

__device__ __forceinline__ void gla_prep_phase(Frame& F, const Args& A, bf16* QGl, bf16* QGc, float* EGL) {
    const int gw = F.mi * NWAVES + F.wave, NGW = 32 * NWAVES, lane = F.lane;
    const float qscale = 0.08838834764831845f;
    LAS float* av = (LAS float*)(F.lds + F.wave * 4096);
    for (int task = gw; task < 144; task += NGW) {
        const int cgp = task & 1, dir = (task >> 1) & 1, lb = task >> 2, blk = lb < 32 ? F.grp * 32 + lb : 256 + F.grp * 4 + (lb - 32);
        const bool lat = blk < 256;
        const int rowbase = lat ? (blk >> 5) * TL + (blk & 31) * 64 : ML + ((blk - 256) >> 2) * TC + ((blk - 256) & 3) * 64;
        const int c4 = cgp * 256 + lane * 4;
        { const float* ap = F.G32 + (size_t)(rowbase + (dir == 0 ? lane : 63 - lane)) * 32 + dir * 16;
#pragma unroll
          for (int r4 = 0; r4 < 4; ++r4) *(LAS f32x4*)(av + lane * 16 + r4 * 4) = *(const f32x4*)(ap + r4 * 4); }
        float w2r[16][4], bzv[4], run[4];
#pragma unroll
        for (int r = 0; r < 16; ++r) { const f32x4 w = *(const f32x4*)(A.in[18] + (size_t)(dir * 16 + r) * 512 + c4); w2r[r][0] = w.x; w2r[r][1] = w.y; w2r[r][2] = w.z; w2r[r][3] = w.w; }
        { const f32x4 w = *(const f32x4*)(A.in[19] + dir * 512 + c4); bzv[0] = w.x; bzv[1] = w.y; bzv[2] = w.z; bzv[3] = w.w; }
#pragma unroll
        for (int i = 0; i < 4; ++i) run[i] = 0.f;
        v2u qn[4], kn[4];
#pragma unroll
        for (int t = 0; t < 4; ++t) { const int row = rowbase + (dir == 0 ? t : 63 - t); qn[t] = *(const v2u*)(F.P16 + (size_t)row * PLD + c4); kn[t] = *(const v2u*)(F.P16 + (size_t)row * PLD + 512 + c4); }
        for (int jb = 0; jb < 16; ++jb) {
            v2u qc_[4], kc_[4];
#pragma unroll
            for (int t = 0; t < 4; ++t) { qc_[t] = qn[t]; kc_[t] = kn[t]; }
            if (jb < 15) {
#pragma unroll
                for (int t = 0; t < 4; ++t) { const int jj = (jb + 1) * 4 + t; const int row = rowbase + (dir == 0 ? jj : 63 - jj); qn[t] = *(const v2u*)(F.P16 + (size_t)row * PLD + c4); kn[t] = *(const v2u*)(F.P16 + (size_t)row * PLD + 512 + c4); } }
#pragma unroll
            for (int t = 0; t < 4; ++t) {
                const int jj = jb * 4 + t; const int row = rowbase + (dir == 0 ? jj : 63 - jj);
                float z[4] = {bzv[0], bzv[1], bzv[2], bzv[3]};
#pragma unroll
                for (int r4 = 0; r4 < 4; ++r4) { const f32x4 a4 = *(const LAS f32x4*)(av + jj * 16 + r4 * 4);
#pragma unroll
                    for (int i = 0; i < 4; ++i) z[i] += a4.x * w2r[r4 * 4][i] + a4.y * w2r[r4 * 4 + 1][i] + a4.z * w2r[r4 * 4 + 2][i] + a4.w * w2r[r4 * 4 + 3][i]; }
                const float qf[4] = {bflo(qc_[t].x), bfhi(qc_[t].x), bflo(qc_[t].y), bfhi(qc_[t].y)}, kf[4] = {bflo(kc_[t].x), bfhi(kc_[t].x), bflo(kc_[t].y), bfhi(kc_[t].y)};
                float oq[4], ok[4];
#pragma unroll
                for (int i = 0; i < 4; ++i) { run[i] += (fminf(z[i], 0.f) - __logf(1.0f + __expf(-fabsf(z[i])))) * 0.0625f; const float eg = __expf(run[i]); oq[i] = qf[i] * qscale * eg; ok[i] = kf[i] * __builtin_amdgcn_rcpf(eg); }
                bf16* dst = (lat ? QGl + (size_t)row * 2048 : QGc + (size_t)(row - ML) * 2048) + dir * 1024 + c4;
                v2u o1; o1.x = pk2(oq[0], oq[1]); o1.y = pk2(oq[2], oq[3]); *(v2u*)dst = o1;
                v2u o2; o2.x = pk2(ok[0], ok[1]); o2.y = pk2(ok[2], ok[3]); *(v2u*)(dst + 512) = o2;
            }
        }
        *(f32x4*)(EGL + (size_t)blk * 1024 + dir * 512 + c4) = (f32x4){__expf(run[0]), __expf(run[1]), __expf(run[2]), __expf(run[3])};
    }
}
__device__ __forceinline__ void gla_phase(Frame& F, const Args& A, const bf16* QGl, const bf16* QGc, const float* EGL) {
    const int tid = F.tid, lane = F.lane, wave = F.wave, fr = lane & 15, fq = lane >> 4;
    for (int task = F.vcu; task < 256; task += F.G) {
        const int eq = task & 3, dir = (task >> 2) & 1, h = (task >> 3) & 3, b = task >> 5;
        const int e0 = eq * 64;
        bf16* Oout = dir == 0 ? F.H16 : F.HB16;
        __syncthreads();
        for (int i = tid; i < 64 * 136 / 2; i += NTHR) ((LAS unsigned*)(F.lds + 88064))[i] = 0u;
        f32x4 st[4];
#pragma unroll
        for (int k = 0; k < 4; ++k) st[k] = (f32x4){0.f, 0.f, 0.f, 0.f};
        const int s = tid >> 3, cg = tid & 7;
        v4u rq0, rq1, rk0, rk1, rv0, rv1; float egn[4], egc[4];
#define GLA_LOAD(stepn) do { const bool ic_ = (stepn) < 4; const int c_ = ic_ ? (stepn) : (stepn) - 4, Tn_ = ic_ ? TC : TL; \
            const int t0_ = dir == 0 ? c_ * 64 : Tn_ - 64 * (c_ + 1), pos_ = dir == 0 ? t0_ + s : t0_ + 63 - s; \
            const bf16* qg_ = (ic_ ? QGc + (size_t)(b * TC + pos_) * 2048 : QGl + (size_t)(b * TL + pos_) * 2048) + dir * 1024 + h * 128 + cg * 16; \
            rq0 = *(const v4u*)(qg_); rq1 = *(const v4u*)(qg_ + 8); rk0 = *(const v4u*)(qg_ + 512); rk1 = *(const v4u*)(qg_ + 520); \
            if (cg < 4) { const bf16* pv_ = F.P16 + (size_t)((ic_ ? ML + b * TC : b * TL) + pos_) * PLD + 1024 + h * 256 + e0 + cg * 16; rv0 = *(const v4u*)(pv_); rv1 = *(const v4u*)(pv_ + 8); } \
            const int blk_ = ic_ ? 256 + b * 4 + (t0_ >> 6) : b * 32 + (t0_ >> 6); \
            _Pragma("unroll") for (int k_ = 0; k_ < 4; ++k_) egn[k_] = EGL[(size_t)blk_ * 1024 + dir * 512 + h * 128 + 16 * ((wave & 1) * 4 + k_) + fr]; } while (0)
        GLA_LOAD(0);
        for (int step = 0; step < 36; ++step) {
            const int p = step & 1;
            LAS bf16* Qg = (LAS bf16*)(F.lds + p * 44032);
            LAS bf16* Kg = (LAS bf16*)(F.lds + p * 44032 + 17408);
            LAS bf16* Vs = (LAS bf16*)(F.lds + p * 44032 + 34816);
            const LAS bf16* STr = (const LAS bf16*)(F.lds + 88064 + p * 17408);
            LAS bf16* STw = (LAS bf16*)(F.lds + 88064 + (p ^ 1) * 17408);
            const bool isctx = step < 4; const int c = isctx ? step : step - 4; const int Tn = isctx ? TC : TL;
            const int rowbase = isctx ? ML + b * TC : b * TL;
            const int t0 = dir == 0 ? c * 64 : Tn - 64 * (c + 1);
            *(LAS v4u*)(Qg + s * 136 + cg * 16) = rq0; *(LAS v4u*)(Qg + s * 136 + cg * 16 + 8) = rq1;
            *(LAS v4u*)(Kg + s * 136 + cg * 16) = rk0; *(LAS v4u*)(Kg + s * 136 + cg * 16 + 8) = rk1;
            if (cg < 4) { *(LAS v4u*)(Vs + s * 72 + cg * 16) = rv0; *(LAS v4u*)(Vs + s * 72 + cg * 16 + 8) = rv1; }
#pragma unroll
            for (int k = 0; k < 4; ++k) egc[k] = egn[k];
            if (step + 1 < 36) GLA_LOAD(step + 1);
            asm volatile("s_waitcnt lgkmcnt(0)" ::: "memory"); __builtin_amdgcn_s_barrier(); asm volatile("" ::: "memory");
            {
                const int jt = wave >> 1, ep = (wave & 1) * 2;
                bf16x8 qb[4];
#pragma unroll
                for (int ks = 0; ks < 4; ++ks) qb[ks] = ldfrag(Qg, 136, 16 * jt, 32 * ks, lane);
                f32x4 oT[2];
                {
                    bf16x8 sf[8];
#pragma unroll
                    for (int t2 = 0; t2 < 2; ++t2)
#pragma unroll
                        for (int ks = 0; ks < 4; ++ks) sf[t2 * 4 + ks] = ldfrag(STr, 136, 16 * (ep + t2), 32 * ks, lane);
                    PIN4(qb[0], qb[1], qb[2], qb[3]); PIN8(sf[0], sf[1], sf[2], sf[3], sf[4], sf[5], sf[6], sf[7]);
                    f32x4 o0 = {0.f, 0.f, 0.f, 0.f}, o1 = o0, o2 = o0, o3 = o0;
                    o0 = MFMA16(sf[0], qb[0], o0); o1 = MFMA16(sf[4], qb[0], o1); o2 = MFMA16(sf[1], qb[1], o2); o3 = MFMA16(sf[5], qb[1], o3);
                    o0 = MFMA16(sf[2], qb[2], o0); o1 = MFMA16(sf[6], qb[2], o1); o2 = MFMA16(sf[3], qb[3], o2); o3 = MFMA16(sf[7], qb[3], o3);
                    oT[0] = o0 + o2; oT[1] = o1 + o3;
                }
                for (int sp = 0; sp <= (jt >> 1); ++sp) {
                    const int ts0 = 2 * sp, ts1 = 2 * sp + 1;
                    bf16x8 kf[8];
#pragma unroll
                    for (int ks = 0; ks < 4; ++ks) { kf[ks] = ldfrag(Kg, 136, 16 * ts0, 32 * ks, lane); kf[4 + ks] = ldfrag(Kg, 136, 16 * ts1, 32 * ks, lane); }
                    bf16x8 vf0 = ldfrag_tr4(Vs, 72, 32 * sp, 16 * ep, lane), vf1 = ldfrag_tr4(Vs, 72, 32 * sp, 16 * (ep + 1), lane);
                    PIN8(kf[0], kf[1], kf[2], kf[3], kf[4], kf[5], kf[6], kf[7]); PIN2(vf0, vf1);
                    f32x4 aT0 = {0.f, 0.f, 0.f, 0.f}, aT1 = aT0, aT2 = aT0, aT3 = aT0;
                    aT0 = MFMA16(kf[0], qb[0], aT0); aT1 = MFMA16(kf[4], qb[0], aT1); aT2 = MFMA16(kf[1], qb[1], aT2); aT3 = MFMA16(kf[5], qb[1], aT3);
                    aT0 = MFMA16(kf[2], qb[2], aT0); aT1 = MFMA16(kf[6], qb[2], aT1); aT2 = MFMA16(kf[3], qb[3], aT2); aT3 = MFMA16(kf[7], qb[3], aT3);
                    aT0 = aT0 + aT2; aT1 = aT1 + aT3;
#pragma unroll
                    for (int reg = 0; reg < 4; ++reg) { const bool v0 = (ts0 < jt) || (4 * fq + reg <= fr), v1 = (ts1 < jt) || (ts1 == jt && 4 * fq + reg <= fr);
                        aT0[reg] = v0 ? aT0[reg] : 0.f; aT1[reg] = v1 ? aT1[reg] : 0.f; }
                    const bf16x8 pf = cvt8_mma(aT0[0], aT0[1], aT0[2], aT0[3], aT1[0], aT1[1], aT1[2], aT1[3]);
                    oT[0] = MFMA16(vf0, pf, oT[0]); oT[1] = MFMA16(vf1, pf, oT[1]);
                }
                const int jj = 16 * jt + fr; const int pos = dir == 0 ? t0 + jj : t0 + 63 - jj;
                bf16* op = Oout + (size_t)(rowbase + pos) * D + h * 256 + e0 + 4 * fq;
#pragma unroll
                for (int t2 = 0; t2 < 2; ++t2) { v2u w; w.x = pk2(oT[t2][0], oT[t2][1]); w.y = pk2(oT[t2][2], oT[t2][3]); *(v2u*)(op + 16 * (ep + t2)) = w; }
            }
            {
                const int et = wave >> 1;
                bf16x8 va0 = ldfrag_tr(Vs, 72, 0, 16 * et, lane), va1 = ldfrag_tr(Vs, 72, 32, 16 * et, lane);
                bf16x8 kb[8];
#pragma unroll
                for (int k = 0; k < 4; ++k) { const int dt = (wave & 1) * 4 + k; kb[2 * k] = ldfrag_tr(Kg, 136, 0, 16 * dt, lane); kb[2 * k + 1] = ldfrag_tr(Kg, 136, 32, 16 * dt, lane); }
                PIN2(va0, va1); PIN8(kb[0], kb[1], kb[2], kb[3], kb[4], kb[5], kb[6], kb[7]);
#pragma unroll
                for (int k = 0; k < 4; ++k) st[k] = MFMA16(va0, kb[2 * k], st[k]);
#pragma unroll
                for (int k = 0; k < 4; ++k) st[k] = MFMA16(va1, kb[2 * k + 1], st[k]);
#pragma unroll
                for (int k = 0; k < 4; ++k) { const int dt = (wave & 1) * 4 + k; st[k] = st[k] * egc[k];
#pragma unroll
                    for (int reg = 0; reg < 4; ++reg) STw[(16 * et + 4 * fq + reg) * 136 + 16 * dt + fr] = (bf16)f2bf(st[k][reg]); }
            }
        }
#undef GLA_LOAD
    }
}
__device__ __forceinline__ void gla_combine_phase(Frame& F, const Args& A, int nrows) {
    const int gw = F.mi * NWAVES + F.wave, NGW = 32 * NWAVES, nloc = nrows == MT ? TL + TC : TL;
    float ng[16];
#pragma unroll
    for (int i = 0; i < 16; ++i) ng[i] = A.in[20][(F.lane & 15) * 16 + i];
    for (int lr = gw; lr < nloc; lr += NGW) { const int row = grow(F, lr);
        bf16* of = F.H16 + (size_t)row * D + F.lane * 16; const bf16* ob = F.HB16 + (size_t)row * D + F.lane * 16; const bf16* rr = F.P16 + (size_t)row * PLD + 2048 + F.lane * 16;
        float o[16], a[8], b2[8]; float ss = 0.f;
#pragma unroll
        for (int hv = 0; hv < 2; ++hv) { unpack8(*(const v4u*)(of + hv * 8), a); unpack8(*(const v4u*)(ob + hv * 8), b2);
#pragma unroll
            for (int i = 0; i < 8; ++i) { o[hv * 8 + i] = a[i] + b2[i]; ss += o[hv * 8 + i] * o[hv * 8 + i]; } }
        ss += __shfl_xor(ss, 1); ss += __shfl_xor(ss, 2); ss += __shfl_xor(ss, 4); ss += __shfl_xor(ss, 8);
        const float rinv = 1.0f / sqrtf(ss * (1.f / 256.f) + EPS);
#pragma unroll
        for (int hv = 0; hv < 2; ++hv) { float g[8], y[8]; unpack8(*(const v4u*)(rr + hv * 8), g);
#pragma unroll
            for (int i = 0; i < 8; ++i) y[i] = o[hv * 8 + i] * rinv * ng[hv * 8 + i] * siluf_(g[i]);
            *(v4u*)(of + hv * 8) = pack8(y); }
    }
}

#define NA_SOFTMAX_PV(LOC_, VT_, S0_) do { \
        float sv[8]; float gmax = -INFINITY; \
        _Pragma("unroll") for (int t = 0; t < 2; ++t) _Pragma("unroll") for (int reg = 0; reg < 4; ++reg) { float x = (t == 0 ? sT0[reg] : sT1[reg]) * 0.125f; \
            if (LOC_) { const int col_k = kst + 16 * t + 4 * fq + reg; const bool valid = (col_k >= cst) && (col_k < cst + 16); \
                const int dc = min(max(col_k - col_q + 15, 0), 30), dr = rs + gi - r + 7; x = valid ? x + rpb[dr * 31 + dc] : -INFINITY; } \
            sv[t * 4 + reg] = x; gmax = fmaxf(gmax, x); } \
        gmax = fmaxf(gmax, __shfl_xor(gmax, 16)); gmax = fmaxf(gmax, __shfl_xor(gmax, 32)); \
        const float m_new = fmaxf(m_run, gmax), alpha = __expf(m_run - m_new); \
        float ps = 0.f; float pv[8]; \
        _Pragma("unroll") for (int i = 0; i < 8; ++i) { pv[i] = __expf(sv[i] - m_new); ps += pv[i]; } \
        l_part = l_part * alpha + ps; m_run = m_new; \
        const bf16x8 pf = cvt8_mma(pv[0], pv[1], pv[2], pv[3], pv[4], pv[5], pv[6], pv[7]); \
        _Pragma("unroll") for (int et = 0; et < 4; ++et) oT[et] = oT[et] * alpha; \
        oT[0] = MFMA16(vf0, pf, oT[0]); oT[1] = MFMA16(vf1, pf, oT[1]); oT[2] = MFMA16(vf2, pf, oT[2]); oT[3] = MFMA16(vf3, pf, oT[3]); } while (0)
__device__ __forceinline__ void na_phase(Frame& F, const Args& A) {
    LAS bf16* Vl = (LAS bf16*)(F.lds + 0);
    LAS bf16* Vc = (LAS bf16*)(F.lds + 82944);
    LAS bf16* Kc = (LAS bf16*)(F.lds + 119808);
    LAS float* rpb = (LAS float*)(F.lds + 156672);
    const int tid = F.tid, lane = F.lane, wave = F.wave, fr = lane & 15, fq = lane >> 4;
    const bf16* P = F.P16;
    for (int wg = F.vcu; wg < 256; wg += F.G) {
        const int bh = wg >> 1, b = bh >> 4, h = bh & 15, odd = wg & 1;
        __syncthreads();
        for (int it = tid; it < 256 * 8; it += NTHR) { const int tok = it >> 3, eg = it & 7; const bf16* src = P + (size_t)(ML + b * TC + tok) * PLD + h * 64 + eg * 8;
            *(LAS v4u*)(Vc + tok * 72 + eg * 8) = *(const v4u*)(src + 2048); *(LAS v4u*)(Kc + tok * 72 + eg * 8) = *(const v4u*)(src + 1024); }
        for (int i = tid; i < 465; i += NTHR) rpb[i] = A.in[23][h * 465 + i];
        int have_hi = -1;
        for (int si = 0; si < 9; ++si) { const int sub = si < 8 ? odd * 8 + si : 16 + odd;
            const bool lat = sub < 16;
            const int rp = lat ? sub : 0, half = lat ? 0 : sub - 16;
            const int r0 = 2 * rp, rs0 = min(max(r0 - 4, 0), 24), nrw = min(9, 32 - rs0);
            const int r = r0 + (wave >> 2), n = wave & 3;
            const int rs = min(max(r - 4, 0), 24), kst = min(max(16 * n - 8, 0), 32);
            const int qrow = lat ? b * TL + r * 64 + 16 * n + fr : ML + b * TC + 16 * (half * 8 + wave) + fr;
            const bf16x8 qf0 = *(const bf16x8*)(P + (size_t)qrow * PLD + h * 64 + 8 * fq), qf1 = *(const bf16x8*)(P + (size_t)qrow * PLD + h * 64 + 32 + 8 * fq);
            bf16x8 ka[4], kb[4];
#define NA_KLOAD(kd_, gi_) do { const bf16* kp_ = P + (size_t)(b * TL + (rs + (gi_)) * 64 + kst + fr) * PLD + 1024 + h * 64 + 8 * fq; \
                    kd_[0] = *(const bf16x8*)(kp_); kd_[1] = *(const bf16x8*)(kp_ + 32); kd_[2] = *(const bf16x8*)(kp_ + (size_t)16 * PLD); kd_[3] = *(const bf16x8*)(kp_ + (size_t)16 * PLD + 32); } while (0)
            if (lat) { NA_KLOAD(ka, 0); NA_KLOAD(kb, 1); }
            asm volatile("s_waitcnt lgkmcnt(0)" ::: "memory"); __builtin_amdgcn_s_barrier(); asm volatile("" ::: "memory");
            if (lat) {
                const int lo = have_hi < 0 ? rs0 : max(rs0, have_hi), hi = rs0 + nrw;
                for (int it = tid; it < (hi - lo) * 64 * 8; it += NTHR) { const int rw = lo + (it >> 9), tk = (it >> 3) & 63, eg = it & 7;
                    *(LAS v4u*)(Vl + ((rw % 9) * 64 + tk) * 72 + eg * 8) = *(const v4u*)(P + (size_t)(b * TL + rw * 64 + tk) * PLD + 2048 + h * 64 + eg * 8); }
                have_hi = hi;
            }
            asm volatile("s_waitcnt lgkmcnt(0)" ::: "memory"); __builtin_amdgcn_s_barrier(); asm volatile("" ::: "memory");
            const int col_q = 16 * n + fr, cst = min(max(col_q - 8, 0), 48);
            float m_run = -INFINITY, l_part = 0.f;
            f32x4 oT[4];
#pragma unroll
            for (int et = 0; et < 4; ++et) oT[et] = (f32x4){0.f, 0.f, 0.f, 0.f};
            if (lat) {
#define NA_WGROUP(kd_, gi_) do { const int gi = (gi_); const bf16x8 k00 = kd_[0], k01 = kd_[1], k10 = kd_[2], k11 = kd_[3]; \
                    if (gi + 2 < 8) NA_KLOAD(kd_, gi + 2); \
                    const int s0 = ((rs + gi) % 9) * 64 + kst; \
                    bf16x8 vf0 = ldfrag_tr4(Vl, 72, s0, 0, lane), vf1 = ldfrag_tr4(Vl, 72, s0, 16, lane), vf2 = ldfrag_tr4(Vl, 72, s0, 32, lane), vf3 = ldfrag_tr4(Vl, 72, s0, 48, lane); \
                    f32x4 sT0 = {0.f, 0.f, 0.f, 0.f}, sT1 = sT0; \
                    sT0 = MFMA16(k00, qf0, sT0); sT1 = MFMA16(k10, qf0, sT1); sT0 = MFMA16(k01, qf1, sT0); sT1 = MFMA16(k11, qf1, sT1); \
                    NA_SOFTMAX_PV(true, Vl, s0); } while (0)
#pragma unroll 1
                for (int g2 = 0; g2 < 8; g2 += 2) { NA_WGROUP(ka, g2); NA_WGROUP(kb, g2 + 1); }
#undef NA_WGROUP
#undef NA_KLOAD
            }
#pragma unroll 1
            for (int gc = 0; gc < 8; ++gc) {
                const int gi = 8 + gc; (void)gi;
                bf16x8 k00 = ldfrag(Kc, 72, 32 * gc, 0, lane), k01 = ldfrag(Kc, 72, 32 * gc, 32, lane), k10 = ldfrag(Kc, 72, 32 * gc + 16, 0, lane), k11 = ldfrag(Kc, 72, 32 * gc + 16, 32, lane);
                bf16x8 vf0 = ldfrag_tr4(Vc, 72, 32 * gc, 0, lane), vf1 = ldfrag_tr4(Vc, 72, 32 * gc, 16, lane), vf2 = ldfrag_tr4(Vc, 72, 32 * gc, 32, lane), vf3 = ldfrag_tr4(Vc, 72, 32 * gc, 48, lane);
                PIN4(k00, k01, k10, k11);
                f32x4 sT0 = {0.f, 0.f, 0.f, 0.f}, sT1 = sT0;
                sT0 = MFMA16(k00, qf0, sT0); sT1 = MFMA16(k10, qf0, sT1); sT0 = MFMA16(k01, qf1, sT0); sT1 = MFMA16(k11, qf1, sT1);
                NA_SOFTMAX_PV(false, Vc, 0);
            }
            float l = l_part; l += __shfl_xor(l, 16); l += __shfl_xor(l, 32);
            const float inv = 1.0f / l;
            bf16* op = F.H16 + (size_t)qrow * D + h * 64 + 4 * fq;
#pragma unroll
            for (int et = 0; et < 4; ++et) { v2u w; w.x = pg8::cvt_pk_bf16(oT[et][0] * inv, oT[et][1] * inv); w.y = pg8::cvt_pk_bf16(oT[et][2] * inv, oT[et][3] * inv); *(v2u*)(op + 16 * et) = w; }
        }
    }
}
constexpr int N_PHASES = 42;

#ifndef STAG
#define STAG 1
#endif
#ifndef SLP
#define SLP 64
#endif
#ifndef GSTAG
#define GSTAG 0
#endif
template <class Epi, bool SWAP>
__device__ __forceinline__ void run_gemm(Frame& F, const bf16* A, const bf16* Bt, int npan, int N, int K, const Epi& E) {
    pg8::Gemm g{A, Bt, MT, N, K}; GroupOrder S; S.g = F.grp; S.mi = F.mi; S.npan = npan; S.nN = N / 256; S.ntK = K / 64; S.wid = F.wave;
    if (STAG) {
        const int rem = (npan * (N / 256)) % 32;
        if (rem != 0 && F.mi >= rem) { const int st = ((F.mi - rem) & 3) + 1; for (int i = 0; i < st * STAG; ++i) __builtin_amdgcn_s_sleep(SLP); }
    }
    pg8::gemm_phase<Epi, GroupOrder, true, true, SWAP>(F.lds, g, S, E);
}
__device__ __forceinline__ void run_resid_gemm(Frame& F, const bf16* A, const bf16* Bt, int K, bool with_ctx, const float* gate, float* slab) {
    pg8::Gemm g{A, Bt, MT, D, K}; GroupSplitOrder S; S.g = F.grp; S.mi = F.mi; S.ntK = K / 64; S.np = with_ctx ? 16 : 0; S.wid = F.wave; EpiResidSplit E{F.X, gate, slab, 0};
    pg8::gemm_phase<EpiResidSplit, GroupSplitOrder, true, true, false>(F.lds, g, S, E);
}
__global__ void __launch_bounds__(NTHR, 2) fwd_kernel(Args args) {
    extern __shared__ __attribute__((aligned(16))) unsigned char lds_raw[];
    Frame F;
    F.lds = (LAS unsigned char*)lds_raw;
    F.wave = __builtin_amdgcn_readfirstlane((int)threadIdx.x >> 6); F.lane = lane_id_now(); F.tid = F.wave * 64 + F.lane;
    F.G = gridDim.x; { const int bx = blockIdx.x; F.vcu = (bx % 8) * 32 + bx / 8; }
    F.grp = F.vcu >> 5; F.mi = F.vcu & 31; F.gph = 0u;
    F.ws = args.ws;
    F.X = (bf16*)(args.ws + WS_X); F.H16 = (bf16*)(args.ws + WS_H16); F.HB16 = (bf16*)(args.ws + WS_HB16); F.P16 = (bf16*)(args.ws + WS_P16);
    F.G32 = (float*)(args.ws + WS_G32); F.EDGE = (float*)(args.ws + WS_EDGE); F.MOD = (float*)(args.ws + WS_MOD);
    volatile LAS unsigned* MISC = (volatile LAS unsigned*)(F.lds + MISC_OFF);
    for (int u = F.tid; u < 128; u += NTHR) MISC[u] = 0u;
    __syncthreads();
    unsigned* bw = (unsigned*)(args.ws + WS_CTL) + 4096;
    XcdBarrier bar = xcd_barrier_post(bw, MISC + 8, F.wave == 0);
#define GSEAM() do { F.lane = lane_id_now(); F.tid = F.wave * 64 + F.lane; grp_barrier(bw, F.grp, F.gph, F.tid, F.same_l2); } while (0)
#define RELANE() do { F.lane = lane_id_now(); F.tid = F.wave * 64 + F.lane; } while (0)

    if (F.tid == 0) __hip_atomic_store(&bw[GB_XID(F.vcu)], xb_xcc_id() + 1u, __ATOMIC_RELAXED, __HIP_MEMORY_SCOPE_AGENT);
    convert_layer_weights(F, args, 0, F.vcu * NWAVES + F.wave, F.G * NWAVES); p0_adaln(F, args, 0, F.vcu, F.G);
    xcd_barrier(bar);
    { const unsigned v = xb_ld(&bw[GB_XID(F.grp * 32 + (lane_id_now() & 31))]); F.same_l2 = __all(v == xb_xcc_id() + 1u) != 0; }
    for (int i = 0; i < F.grp * GSTAG; ++i) __builtin_amdgcn_s_sleep(SLP);

    float* slab = (float*)(args.ws + WS_SLAB); float* EGL = (float*)(args.ws + WS_EGL);
    for (int layer = 0; layer < DEPTH; ++layer) {
        RELANE();
        const int kind = layer % 3, jk = layer / 3;
        const bool last = layer == DEPTH - 1;
        const int Mff = last ? ML : MT, npan = last ? 8 : 9;
        const float* modl = F.MOD + (size_t)layer * 9 * 6144;
        const int nN_in = kind == 2 ? 12 : 13;
        if (layer > 0) { const int pk = (layer - 1) % 3, pu = 9 * (pk == 2 ? 12 : 13), prem = pu % 32; flag_wait(bw, FL_M(layer), 8u * (unsigned)(prem == 0 ? 32 : 32 - prem), F.tid); }
        RELANE(); norm_phase(F, args, layer, 0, layer == 0, MT, layer > 0 ? slab : nullptr, F.MOD + (size_t)((layer > 0 ? layer - 1 : 0) * 9 + 8) * 6144 + 5120); GSEAM();
        if (layer > 0) { const int prem = (9 * 22) % 32; flag_wait(bw, FL_W(layer), 8u * (unsigned)(32 - prem), F.tid); }
        { RELANE();
            EpiInproj E{F.P16, F.G32};
            run_gemm<EpiInproj, false>(F, F.H16, wb_ptr(F, layer, WB_IN), 9, nN_in * 256, D, E);
            if (!last) {
                const int rem = (9 * nN_in) % 32, nidle = rem == 0 ? 32 : 32 - rem, iidx = rem == 0 ? F.mi : F.mi - rem;
                if (iidx >= 0) { p0_adaln(F, args, layer + 1, F.grp * nidle + iidx, 8 * nidle); flag_signal(bw, FL_M(layer + 1), F.tid); }
            }
            GSEAM();
        }
        bf16* QKl = kind == 0 ? (bf16*)args.out + (size_t)F.grp * TL * D : (bf16*)args.out;
        bf16* QKc = (bf16*)(args.ws + WS_SCR);
        if (kind == 0) { RELANE(); mlstm_prep_phase(F, args, jk, QKl, QKc); GSEAM(); }
        else if (kind == 1) { RELANE(); gla_prep_phase(F, args, QKl, QKc, EGL); GSEAM(); }
        { RELANE();
            if (kind == 0) mlstm_phase(F, args, jk, QKl, QKc, (f32x4*)(args.ws + WS_GATES));
            else if (kind == 1) gla_phase(F, args, QKl, QKc, EGL);
            else na_phase(F, args);
            GSEAM();
        }
        if (kind == 0) { RELANE(); mlstm_combine_phase(F, args, Mff); GSEAM(); }
        else if (kind == 1) { RELANE(); gla_combine_phase(F, args, Mff); GSEAM(); }
        { RELANE(); run_resid_gemm(F, F.H16, wb_ptr(F, layer, WB_OUT), D, !last, modl + 2048, slab); GSEAM(); }
        { RELANE(); norm_phase(F, args, layer, 1, false, Mff, last ? nullptr : slab, modl + (size_t)8 * 6144 + 2048); GSEAM(); }
        { RELANE();
            EpiConvGate E{F.P16, F.EDGE, args.in[9] + (size_t)layer * 3 * FF2, args.in[10] + (size_t)layer * FF2, (LAS float*)(F.lds + CE_OFF)};
            run_gemm<EpiConvGate, true>(F, F.H16, wb_ptr(F, layer, WB_UP), npan, FF2, D, E);
            if (!last) {
                const int rem = (npan * 22) % 32, nidle = rem == 0 ? 32 : 32 - rem, iidx = rem == 0 ? F.mi : F.mi - rem;
                if (iidx >= 0) { convert_layer_weights(F, args, layer + 1, (F.grp * nidle + iidx) * NWAVES + F.wave, 8 * nidle * NWAVES); flag_signal(bw, FL_W(layer + 1), F.tid); }
            }
            GSEAM();
        }
        { RELANE(); ffn_fixup_phase(F, args, layer); GSEAM(); }
        { RELANE(); run_resid_gemm(F, F.P16, wb_ptr(F, layer, WB_DN), FF, !last, modl + 5120, slab); GSEAM(); }
    }
    RELANE(); final_norm_phase(F, args);
#undef GSEAM
#undef RELANE
}

#ifndef MK_PER_PHASE
#define MK_PER_PHASE 0
#endif
extern "C" void kernel_launch(void* const* d_in, const int* in_sizes, int n_in, void* d_out, int out_size, void* d_ws, size_t ws_size, hipStream_t stream) {
    static int grid = 0;
    if (grid == 0) {
        if (n_in != 26 || out_size != ML * D || ws_size < WS_END) { fprintf(stderr, "kernel_launch: unexpected shapes: n_in %d out %d ws %zu (need %zu)\n", n_in, out_size, ws_size, (size_t)WS_END); grid = -1; return; }
        int dev = 0, cus = 0, per_cu = 0;
        if (hipGetDevice(&dev) != hipSuccess || hipDeviceGetAttribute(&cus, hipDeviceAttributeMultiprocessorCount, dev) != hipSuccess) { grid = -1; return; }
        if (hipFuncSetAttribute((const void*)fwd_kernel, hipFuncAttributeMaxDynamicSharedMemorySize, LDS_BYTES) != hipSuccess) { fprintf(stderr, "kernel_launch: hipFuncSetAttribute failed\n"); grid = -1; return; }
        if (hipOccupancyMaxActiveBlocksPerMultiprocessor(&per_cu, (const void*)fwd_kernel, NTHR, LDS_BYTES) != hipSuccess || per_cu < 1) { fprintf(stderr, "kernel_launch: occupancy query failed (%d)\n", per_cu); (void)hipGetLastError(); grid = -1; return; }
        if (cus < 256) { fprintf(stderr, "kernel_launch: needs 256 compute units (8 batch groups of 32 workgroups), found %d\n", cus); grid = -1; return; }
        grid = 256;
        fprintf(stderr, "kernel_launch: grid %d (cus %d, occupancy %d per CU)\n", grid, cus, per_cu);
    }
    if (grid < 0) return;
    if (hipMemsetAsync((char*)d_ws + WS_CTL, 0, CTL_ZERO_BYTES, stream) != hipSuccess) return;
    Args a{};
    for (int i = 0; i < 26; ++i) a.in[i] = (const float*)d_in[i];
    a.out = (float*)d_out; a.ws = (unsigned char*)d_ws;
#if 0
#else
    a.ph_lo = 0; a.ph_hi = N_PHASES;
#ifdef MK_PLAIN_LAUNCH
    hipLaunchKernelGGL(fwd_kernel, dim3(grid), dim3(NTHR), LDS_BYTES, stream, a);
#else
    void* kargs[] = {&a};
    hipError_t e = hipLaunchCooperativeKernel((const void*)fwd_kernel, dim3(grid), dim3(NTHR), kargs, LDS_BYTES, stream);
    if (e != hipSuccess) fprintf(stderr, "kernel_launch: cooperative launch failed: %s (grid %d)\n", hipGetErrorString(e), grid);
#endif
#endif
}
```

```cpp
#include <hip/hip_runtime.h>
#include <cstdio>
#include <cstdint>
namespace pg8 {
#define PG8_LAS __attribute__((address_space(3)))
typedef unsigned short bf16_t;
typedef short bf16x8 __attribute__((ext_vector_type(8)));
typedef float f32x4 __attribute__((ext_vector_type(4)));
typedef unsigned u32x4 __attribute__((ext_vector_type(4)));
constexpr int BM = 256, BK = 64, HALF = 128, HTB = HALF * BK * 2  , STAGE_BYTES = 8 * HTB, NXCD = 8, WGM = 8;

__host__ __device__ __forceinline__ int lds_byte(int r, int c) { const int st = (r >> 4) * 2 + (c >> 5), rr = r & 15, cc = c & 31, ob = rr * 64 + cc * 2; return st * 1024 + (ob ^ (((ob >> 9) & 1) << 5)); }
__host__ __device__ __forceinline__ void stage_rc(int b, int& R, int& C) { const int st = b / 1024, sb = b % 1024, swz = sb ^ (((sb >> 9) & 1) << 5); R = (st >> 1) * 16 + swz / 64; C = (st & 1) * 32 + (swz % 64) / 2; }
__host__ __device__ __forceinline__ int perm32(int rho) { const int n = rho >> 4, i = rho & 15; return 8 * (i >> 2) + 4 * n + (i & 3); }

struct Unit { int pm, pn, k0, nt; };
struct Gemm { const bf16_t* A; const bf16_t* Bt; int M, N, K; };

struct StaticOrder {
    int nM, nN, nwg, G, c, ntK, wid;
    __host__ __device__ void init(int M, int N, int G_, int c_) { nM = M / BM; nN = N / BM; nwg = nM * nN; G = G_; c = c_; }
    __host__ __device__ bool next(int i, Unit& u) const {
        const long L = (long)i * G + c; if (L >= nwg) return false;
        int wgid = (int)L; { const int q = nwg / NXCD, r = nwg % NXCD, xcd = wgid % NXCD, off = wgid / NXCD; wgid = (xcd < r ? xcd * (q + 1) : r * (q + 1) + (xcd - r) * q) + off; }
        const int nig = WGM * nN, gid = wgid / nig, fm = gid * WGM, gsz = (nM - fm) < WGM ? (nM - fm) : WGM;
        u.pm = fm + ((wgid % nig) % gsz); u.pn = (wgid % nig) / gsz; u.k0 = 0; u.nt = ntK; return true;
    }
    __device__ __forceinline__ void a_ready(const Unit&) const {}
    __device__ __forceinline__ void done(const Unit&) const {}
};


__device__ __forceinline__ unsigned cvt_pk_bf16(float lo, float hi) { unsigned r; asm volatile("v_cvt_pk_bf16_f32 %0, %1, %2" : "=v"(r) : "v"(lo), "v"(hi)); return r; }

template <class Epi, class Sched, bool ALIGN_EPI = false, bool SP2 = false, bool SWAP = false>
__device__ __forceinline__ void gemm_phase(PG8_LAS unsigned char* lds, const Gemm g, const Sched& S, const Epi& E) {
    const int wid = S.wid, wr = wid >> 2, wc = wid & 3;
    const int K = g.K; int nt;
    const size_t kstep = (size_t)(BK * 2);
    const size_t hstep = (size_t)HALF * K * 2;
    const size_t tstep = 2 * hstep;
    const unsigned ldsw = (unsigned)wid * 1024u;
    int tid, lane, fr, fq, aoff, boff; unsigned voffA[2], voffB[2];
#define PG8_LANE_SETUP() do { int l_; asm volatile("v_mbcnt_lo_u32_b32 %0, -1, 0\n\tv_mbcnt_hi_u32_b32 %0, -1, %0" : "=v"(l_)); lane = l_; tid = wid * 64 + l_; fr = lane & 15; fq = lane >> 4; \
        _Pragma("unroll") for (int i_ = 0; i_ < 2; ++i_) { int R, C; stage_rc(tid * 16 + i_ * 8192, R, C); const int Rb = Epi::PERM ? ((R & ~31) + perm32(R & 31)) : R; \
            voffA[i_] = (unsigned)(R * K + C) * 2u; voffB[i_] = (unsigned)(Rb * K + C) * 2u; } \
        aoff = lds_byte(wr * 64 + fr, fq * 8); boff = lds_byte(wc * 32 + fr, fq * 8); } while (0)
    PG8_LANE_SETUP();
#define PG8_SA(b, h) (((b) * 2 + (h)) * HTB)
#define PG8_SB(b, h) ((4 + (b) * 2 + (h)) * HTB)
#define PG8_STAGE(bufoff, gbase, voff) do { _Pragma("unroll") for (int _i = 0; _i < 2; ++_i) \
        __builtin_amdgcn_global_load_lds((const unsigned*)((const char*)(gbase) + (voff)[_i]), (PG8_LAS unsigned*)(lds + (bufoff) + ldsw + _i * 8192), 16, 0, 0); } while (0)
#define PG8_LDA(dst, b, h) do { _Pragma("unroll") for (int m = 0; m < 4; ++m) _Pragma("unroll") for (int k = 0; k < 2; ++k) dst[m][k] = *(const PG8_LAS bf16x8*)(lds + PG8_SA(b, h) + aoff + m * 2048 + k * 1024); } while (0)
#define PG8_LDB(dst, b, h) do { _Pragma("unroll") for (int n = 0; n < 2; ++n) _Pragma("unroll") for (int k = 0; k < 2; ++k) dst[n][k] = *(const PG8_LAS bf16x8*)(lds + PG8_SB(b, h) + boff + n * 2048 + k * 1024); } while (0)
#define PG8_MMA(ai, bj, At, Bt) do { __builtin_amdgcn_s_setprio(1); _Pragma("unroll") for (int m = 0; m < 4; ++m) _Pragma("unroll") for (int n = 0; n < 2; ++n) _Pragma("unroll") for (int k = 0; k < 2; ++k) \
        acc[ai][bj][m][n] = SWAP ? __builtin_amdgcn_mfma_f32_16x16x32_bf16(At[m][k], Bt[n][k], acc[ai][bj][m][n], 0, 0, 0) : __builtin_amdgcn_mfma_f32_16x16x32_bf16(Bt[n][k], At[m][k], acc[ai][bj][m][n], 0, 0, 0); __builtin_amdgcn_s_setprio(0); } while (0)
#define PG8_WAIT_V(n) asm volatile("s_waitcnt vmcnt(" #n ")" ::: "memory")
#define PG8_WAIT_L(n) asm volatile("s_waitcnt lgkmcnt(" #n ")" ::: "memory")
#define PG8_BAR __builtin_amdgcn_s_barrier()
#define PG8_SCHED __builtin_amdgcn_sched_barrier(0)
    Unit cur, nxt; int ui = 0;
    if (!S.next(0, cur)) return;
    nt = cur.nt;
    f32x4 acc[2][2][4][2];
#pragma unroll
    for (int a = 0; a < 2; ++a)
#pragma unroll
        for (int b = 0; b < 2; ++b)
#pragma unroll
            for (int m = 0; m < 4; ++m)
#pragma unroll
                for (int n = 0; n < 2; ++n) acc[a][b][m][n] = (f32x4){0.f, 0.f, 0.f, 0.f};
    bf16x8 At[4][2], B0[2][2], B1[2][2];
    const char* cA = (const char*)g.A + (size_t)cur.pm * tstep + (size_t)cur.k0 * 2; const char* cB = (const char*)g.Bt + (size_t)cur.pn * tstep + (size_t)cur.k0 * 2;
    S.a_ready(cur);
    if constexpr (SP2) {
        PG8_STAGE(PG8_SB(0, 0), cB, voffB); PG8_STAGE(PG8_SB(0, 1), cB + hstep, voffB); PG8_STAGE(PG8_SA(0, 0), cA, voffA); PG8_STAGE(PG8_SA(0, 1), cA + hstep, voffA);
        if (wr == 1) PG8_BAR;
        PG8_WAIT_V(2); PG8_BAR;
        PG8_STAGE(PG8_SB(1, 0), cB + kstep, voffB); PG8_STAGE(PG8_SA(1, 0), cA + kstep, voffA); PG8_STAGE(PG8_SB(1, 1), cB + hstep + kstep, voffB);
        PG8_WAIT_V(6); PG8_BAR;
    } else {
        PG8_STAGE(PG8_SB(0, 0), cB, voffB); PG8_STAGE(PG8_SA(0, 0), cA, voffA); PG8_STAGE(PG8_SB(0, 1), cB + hstep, voffB); PG8_STAGE(PG8_SA(0, 1), cA + hstep, voffA);
        if (wr == 1) PG8_BAR;
        PG8_WAIT_V(4); PG8_BAR;
        PG8_STAGE(PG8_SB(1, 0), cB + kstep, voffB); PG8_STAGE(PG8_SA(1, 0), cA + kstep, voffA); PG8_STAGE(PG8_SB(1, 1), cB + hstep + kstep, voffB);
        PG8_WAIT_V(6); PG8_BAR;
    }
    for (;;) {
        const bool has_next = S.next(ui + 1, nxt);
        const char* nA = has_next ? (const char*)g.A + (size_t)nxt.pm * tstep + (size_t)nxt.k0 * 2 : cA; const char* nB = has_next ? (const char*)g.Bt + (size_t)nxt.pn * tstep + (size_t)nxt.k0 * 2 : cB;
        for (int t = 0; t < nt; t += 2) {
            const bool last = (t == nt - 2);
            const char* a1 = cA + (size_t)(t + 1) * kstep;
            const char* a2 = last ? nA : cA + (size_t)(t + 2) * kstep; const char* b2 = last ? nB : cB + (size_t)(t + 2) * kstep;
            const char* a3 = a2 + kstep; const char* b3 = b2 + kstep;
            if (last && has_next) S.a_ready(nxt);
            if constexpr (SP2) {
            PG8_LDB(B0, 0, 0); PG8_LDB(B1, 0, 1); PG8_SCHED; PG8_LDA(At, 0, 0); PG8_STAGE(PG8_SA(1, 1), a1 + hstep, voffA);
            PG8_WAIT_V(8); PG8_WAIT_L(0); PG8_BAR; PG8_MMA(0, 0, At, B0); PG8_MMA(0, 1, At, B1); PG8_BAR; PG8_SCHED;
            PG8_LDA(At, 0, 1); PG8_STAGE(PG8_SB(0, 0), b2, voffB); PG8_STAGE(PG8_SB(0, 1), b2 + hstep, voffB); PG8_STAGE(PG8_SA(0, 0), a2, voffA);
            PG8_WAIT_V(8); PG8_WAIT_L(0); PG8_BAR; PG8_MMA(1, 0, At, B0); PG8_MMA(1, 1, At, B1); PG8_BAR; PG8_SCHED;
            PG8_LDB(B0, 1, 0); PG8_LDB(B1, 1, 1); PG8_SCHED; PG8_LDA(At, 1, 0); PG8_STAGE(PG8_SA(0, 1), a2 + hstep, voffA);
            PG8_WAIT_V(8); PG8_WAIT_L(0); PG8_BAR; PG8_MMA(0, 0, At, B0); PG8_MMA(0, 1, At, B1); PG8_BAR; PG8_SCHED;
            PG8_LDA(At, 1, 1); PG8_STAGE(PG8_SB(1, 0), b3, voffB); PG8_STAGE(PG8_SB(1, 1), b3 + hstep, voffB); PG8_STAGE(PG8_SA(1, 0), a3, voffA);
            PG8_WAIT_V(8); PG8_WAIT_L(0); PG8_BAR; PG8_MMA(1, 0, At, B0); PG8_MMA(1, 1, At, B1); PG8_BAR; PG8_SCHED;
            } else {
            PG8_LDB(B0, 0, 0); PG8_SCHED; PG8_LDA(At, 0, 0); PG8_STAGE(PG8_SA(1, 1), a1 + hstep, voffA);
            PG8_WAIT_L(8); PG8_BAR; PG8_WAIT_L(0); PG8_MMA(0, 0, At, B0); PG8_BAR; PG8_SCHED;
            PG8_LDB(B1, 0, 1); PG8_STAGE(PG8_SB(0, 0), b2, voffB);
            PG8_BAR; PG8_WAIT_L(0); PG8_MMA(0, 1, At, B1); PG8_BAR;
            PG8_LDA(At, 0, 1); PG8_STAGE(PG8_SA(0, 0), a2, voffA);
            PG8_BAR; PG8_WAIT_L(0); PG8_MMA(1, 0, At, B0); PG8_BAR; PG8_SCHED;
            PG8_STAGE(PG8_SB(0, 1), b2 + hstep, voffB);
            PG8_WAIT_V(6); PG8_BAR; PG8_MMA(1, 1, At, B1); PG8_BAR;
            PG8_LDB(B0, 1, 0); PG8_SCHED; PG8_LDA(At, 1, 0); PG8_STAGE(PG8_SA(0, 1), a2 + hstep, voffA);
            PG8_WAIT_L(8); PG8_BAR; PG8_WAIT_L(0); PG8_MMA(0, 0, At, B0); PG8_BAR; PG8_SCHED;
            PG8_LDB(B1, 1, 1); PG8_STAGE(PG8_SB(1, 0), b3, voffB);
            PG8_BAR; PG8_WAIT_L(0); PG8_MMA(0, 1, At, B1); PG8_BAR;
            PG8_LDA(At, 1, 1); PG8_STAGE(PG8_SA(1, 0), a3, voffA);
            PG8_BAR; PG8_WAIT_L(0); PG8_MMA(1, 0, At, B0); PG8_BAR; PG8_SCHED;
            PG8_STAGE(PG8_SB(1, 1), b3 + hstep, voffB);
            PG8_WAIT_V(6); PG8_BAR; PG8_MMA(1, 1, At, B1); PG8_BAR;
            }
        }
        if constexpr (ALIGN_EPI) { if (wr == 0) PG8_BAR; }
        if constexpr (!Epi::AFTER_DRAIN) { E(acc, cur, wr, wc, fr, fq); S.done(cur); if constexpr (SWAP) PG8_LANE_SETUP(); }
        if (!has_next) break;
#pragma unroll
        for (int a = 0; a < 2; ++a)
#pragma unroll
            for (int b = 0; b < 2; ++b)
#pragma unroll
                for (int m = 0; m < 4; ++m)
#pragma unroll
                    for (int n = 0; n < 2; ++n) acc[a][b][m][n] = (f32x4){0.f, 0.f, 0.f, 0.f};
        cur = nxt; cA = nA; cB = nB; nt = cur.nt; ++ui;
        if constexpr (ALIGN_EPI) { if (wr == 1) PG8_BAR; }
    }
    PG8_WAIT_V(0);
    if constexpr (!ALIGN_EPI) { if (wr == 0) PG8_BAR; }
    PG8_BAR;
    if constexpr (Epi::AFTER_DRAIN) { E.fused(acc, cur, wr, wc, fr, fq, lds, wid, lane); S.done(cur); }
#undef PG8_LANE_SETUP
#undef PG8_SA
#undef PG8_SB
#undef PG8_STAGE
#undef PG8_LDA
#undef PG8_LDB
#undef PG8_MMA
#undef PG8_WAIT_V
#undef PG8_WAIT_L
#undef PG8_BAR
#undef PG8_SCHED
}
}

#define GAS __attribute__((address_space(1)))
#define LAS __attribute__((address_space(3)))
typedef unsigned short bf16;
typedef unsigned v4u __attribute__((ext_vector_type(4)));
typedef unsigned v2u __attribute__((ext_vector_type(2)));
typedef float f32x4 __attribute__((ext_vector_type(4)));
typedef float f32x2 __attribute__((ext_vector_type(2)));
typedef short bf16x8 __attribute__((ext_vector_type(8)));
typedef short bf16x4 __attribute__((ext_vector_type(4)));

constexpr int D = 1024, NB = 8, TL = 2048, TC = 256, DEPTH = 4;
constexpr int ML = NB * TL, MC = NB * TC, MT = ML + MC;
constexpr int FF = 2816, FF2 = 5632;
constexpr int NINP = 3328;
constexpr int PLD = 3072;
constexpr float EPS = 1e-6f;
constexpr int NWAVES = 8, NTHR = 512;

constexpr size_t MiB = 1u << 20;
constexpr size_t WS_CTL = 0, CTL_ZERO_BYTES = 65536;
constexpr size_t WS_MOD = 1 * MiB;
constexpr size_t WS_WB = 2 * MiB;
constexpr size_t WB_LAYER = 25 * MiB, WB_IN = 0, WB_OUT = 6815744, WB_UP = WB_OUT + 2097152, WB_DN = WB_UP + 11534336;
static_assert(WB_DN + 5767168 == WB_LAYER, "weights per layer");
constexpr size_t WS_X = 102 * MiB;
constexpr size_t WS_H16 = 174 * MiB;
constexpr size_t WS_HB16 = 210 * MiB;
constexpr size_t WS_P16 = 246 * MiB;
constexpr size_t WS_G32 = 354 * MiB;
constexpr size_t WS_EDGE = 357 * MiB;
constexpr size_t WS_SCR = 364 * MiB;
constexpr size_t WS_GATES = 372 * MiB;
constexpr size_t WS_SLAB = 138 * MiB;
constexpr size_t WS_EGL = 156 * MiB;
constexpr size_t WS_END = 381 * MiB;

constexpr int LDS_BYTES = 163840;
constexpr int MISC_OFF = LDS_BYTES - 512;
constexpr int CE_OFF = MISC_OFF - 8192;

#define RLX_AGENT __ATOMIC_RELAXED, __HIP_MEMORY_SCOPE_AGENT
#define LDS_WAIT() asm volatile("s_waitcnt lgkmcnt(0)" ::: "memory")
#define VM_WAIT() asm volatile("s_waitcnt vmcnt(0)" ::: "memory")
__device__ __forceinline__ unsigned f2bf(float f) { unsigned u = __builtin_bit_cast(unsigned, f); return (u + 0x7fffu + ((u >> 16) & 1u)) >> 16; }
__device__ __forceinline__ unsigned pk2(float lo, float hi) { return f2bf(lo) | (f2bf(hi) << 16); }
__device__ __forceinline__ unsigned cvtpk(float lo, float hi) { unsigned r; asm("v_cvt_pk_bf16_f32 %0, %1, %2" : "=v"(r) : "v"(lo), "v"(hi)); return r; }
__device__ __forceinline__ float bf2f(unsigned h) { return __builtin_bit_cast(float, h << 16); }
__device__ __forceinline__ float bflo(unsigned w) { return __builtin_bit_cast(float, w << 16); }
__device__ __forceinline__ float bfhi(unsigned w) { return __builtin_bit_cast(float, w & 0xffff0000u); }
__device__ __forceinline__ f32x4 ld4bf(const bf16* q) { const v2u w = *(const v2u*)q; return (f32x4){bflo(w.x), bfhi(w.x), bflo(w.y), bfhi(w.y)}; }
__device__ __forceinline__ void unpk8(const v4u w, float* f) { f[0] = bflo(w.x); f[1] = bfhi(w.x); f[2] = bflo(w.y); f[3] = bfhi(w.y); f[4] = bflo(w.z); f[5] = bfhi(w.z); f[6] = bflo(w.w); f[7] = bfhi(w.w); }
__device__ __forceinline__ v4u pk8(const float* f) { v4u w; w.x = pk2(f[0], f[1]); w.y = pk2(f[2], f[3]); w.z = pk2(f[4], f[5]); w.w = pk2(f[6], f[7]); return w; }
__device__ __forceinline__ void st4bf(bf16* q, f32x4 v) { v2u w; w.x = pk2(v.x, v.y); w.y = pk2(v.z, v.w); *(v2u*)q = w; }
__device__ __forceinline__ v4u cvt8_st(float a0, float a1, float a2, float a3, float a4, float a5, float a6, float a7) {
    v4u p;
    asm volatile("v_cvt_pk_bf16_f32 %0, %4, %5\n\tv_cvt_pk_bf16_f32 %1, %6, %7\n\tv_cvt_pk_bf16_f32 %2, %8, %9\n\tv_cvt_pk_bf16_f32 %3, %10, %11\n\ts_nop 0"
                 : "=&v"(p.x), "=&v"(p.y), "=&v"(p.z), "=&v"(p.w) : "v"(a0), "v"(a1), "v"(a2), "v"(a3), "v"(a4), "v"(a5), "v"(a6), "v"(a7));
    return p;
}
__device__ __forceinline__ float sigmoidf_(float x) { return __builtin_amdgcn_rcpf(1.0f + __expf(-x)); }
__device__ __forceinline__ float siluf_(float x) { return x * sigmoidf_(x); }
__device__ __forceinline__ float logsigmoidf_(float x) { return fminf(x, 0.f) - log1pf(__expf(-fabsf(x))); }
__device__ __forceinline__ int lane_id_now() { int l; asm volatile("v_mbcnt_lo_u32_b32 %0, -1, 0\n\tv_mbcnt_hi_u32_b32 %0, -1, %0" : "=v"(l)); return l; }
__device__ __forceinline__ float wave_sum(float v) {
#pragma unroll
    for (int o = 1; o < 64; o <<= 1) v += __shfl_xor(v, o);
    return v;
}

#define XB_TMO      128
#define XB_XCNT(j)  (256  + 64 * (j))
#define XB_XSUB(j)  (1280 + 64 * (j))
#define XB_XGEN(j)  (2304 + 64 * (j))
#define XB_TOP      3328
#define XB_TOPGEN   3392
#define XCD_BAR_WORDS 3456
#define XB_SPIN_CAP (1u << 20)
__device__ __forceinline__ unsigned xb_ld(unsigned* p)              { return __hip_atomic_load(p, __ATOMIC_RELAXED, __HIP_MEMORY_SCOPE_AGENT); }
__device__ __forceinline__ unsigned xb_add(unsigned* p, unsigned v) { return __hip_atomic_fetch_add(p, v, __ATOMIC_RELAXED, __HIP_MEMORY_SCOPE_AGENT); }
__device__ __forceinline__ unsigned xb_xcc_id() { return (unsigned)__builtin_amdgcn_s_getreg((3 << 11) | 20) & 0xFu; }
#define XB_SPIN(cond, bar) do { unsigned _sp = 0; while (cond) { __builtin_amdgcn_s_sleep(1); \
    if ((++_sp & 255u) == 0u) { if (xb_ld(&(bar)[XB_TMO])) break; if (_sp > XB_SPIN_CAP) { atomicAdd(&(bar)[XB_TMO], 1u); break; } } } } while (0)
struct XcdBarrier { unsigned* bar; unsigned x; volatile LAS unsigned* st; bool lead; };
__device__ __forceinline__ XcdBarrier xcd_barrier_post(unsigned* bar, volatile LAS unsigned* st, bool lead0) {
    XcdBarrier b; b.bar = bar; b.x = xb_xcc_id(); b.st = st; b.lead = lead0;
    if (b.lead && lane_id_now() == 0) (void)xb_add(&bar[XB_XCNT(b.x)], 1u);
    return b;
}
__device__ __forceinline__ void xcd_barrier_complete(unsigned* bar, unsigned x, unsigned& nloc, unsigned& nx) {
    const unsigned G = gridDim.x * gridDim.y * gridDim.z;
    unsigned sum, cnt, mine, sp = 0u;
    for (;;) {
        sum = 0u; cnt = 0u; mine = 0u;
#pragma unroll
        for (unsigned j = 0; j < 16; ++j) { const unsigned c = xb_ld(&bar[XB_XCNT(j)]); sum += c; cnt += (c > 0u) ? 1u : 0u; mine = (j == x) ? c : mine; }
        if (sum == G) break;
        __builtin_amdgcn_s_sleep(1);
        if ((++sp & 255u) == 0u) { if (xb_ld(&bar[XB_TMO])) break; if (sp > XB_SPIN_CAP) { atomicAdd(&bar[XB_TMO], 1u); break; } }
    }
    nloc = mine > 0u ? mine : 1u; nx = cnt > 0u ? cnt : 1u;
}
__device__ __forceinline__ void xcd_barrier(const XcdBarrier& b) {
    asm volatile("s_waitcnt vmcnt(0)" ::: "memory");
    __syncthreads();
    if (b.lead && lane_id_now() == 0) {
        unsigned* bar = b.bar;
        __builtin_amdgcn_s_waitcnt(0);
        unsigned nloc = b.st[0], nx = b.st[1];
        if (nloc == 0u) { xcd_barrier_complete(bar, b.x, nloc, nx); b.st[0] = nloc; b.st[1] = nx; }
        const unsigned old = xb_add(&bar[XB_XSUB(b.x)], 1u);
        const unsigned gen = old / nloc;
        if (old + 1u == (gen + 1u) * nloc) {
            __builtin_amdgcn_fence(__ATOMIC_RELEASE, "agent");
            asm volatile("s_waitcnt vmcnt(0)" ::: "memory");
            const unsigned og = xb_add(&bar[XB_TOP], 1u);
            const unsigned tg = og / nx;
            if (og + 1u == (tg + 1u) * nx) xb_add(&bar[XB_TOPGEN], 1u);
            else XB_SPIN(xb_ld(&bar[XB_TOPGEN]) == tg, bar);
            __builtin_amdgcn_fence(__ATOMIC_ACQUIRE, "agent");
            xb_add(&bar[XB_XGEN(b.x)], 1u);
            asm volatile("s_waitcnt vmcnt(0)" ::: "memory");
        } else {
            XB_SPIN(xb_ld(&bar[XB_XGEN(b.x)]) == gen, bar);
            __builtin_amdgcn_fence(__ATOMIC_ACQUIRE, "agent");
            asm volatile("s_waitcnt vmcnt(0)" ::: "memory");
        }
    }
    __syncthreads();
}

#define GB_CNT(g) (4096 + 64 * (g))
#define GB_GEN(g) (4096 + 512 + 64 * (g))
#define FL_W(l)   (4096 + 1024 + 64 * (l))
#define FL_M(l)   (4096 + 1536 + 64 * (l))
#define FL_W2     (4096 + 1536 + 64 * 4)
#define FL_SUB2(g) (7424 + 16 * (g))
#define GB_XID(v) (6144 + (v))
__device__ __forceinline__ void grp_barrier(unsigned* bar, int g, unsigned& ph, int tid, bool same_l2, int fword = -1, unsigned fcount = 0u) {
    asm volatile("s_waitcnt vmcnt(0)" ::: "memory");
    __syncthreads();
    if (tid == 0) {
        if (!same_l2) { __builtin_amdgcn_fence(__ATOMIC_RELEASE, "agent"); asm volatile("s_waitcnt vmcnt(0)" ::: "memory"); }
        const unsigned old = xb_add(&bar[GB_CNT(g)], 1u);
        if (old + 1u == 32u * (ph + 1u)) { __hip_atomic_store(&bar[GB_GEN(g)], ph + 1u, __ATOMIC_RELAXED, __HIP_MEMORY_SCOPE_AGENT); }
        else XB_SPIN(xb_ld(&bar[GB_GEN(g)]) < ph + 1u, bar);
        if (fword >= 0) XB_SPIN(xb_ld(&bar[fword]) < fcount, bar);
        __builtin_amdgcn_fence(__ATOMIC_ACQUIRE, "agent"); asm volatile("s_waitcnt vmcnt(0)" ::: "memory");
    }
    ph += 1u;
    __syncthreads();
}
__device__ __forceinline__ void flag_signal(unsigned* bar, int word, int tid) {
    asm volatile("s_waitcnt vmcnt(0)" ::: "memory");
    __syncthreads();
    if (tid == 0) { __builtin_amdgcn_fence(__ATOMIC_RELEASE, "agent"); asm volatile("s_waitcnt vmcnt(0)" ::: "memory"); xb_add(&bar[word], 1u); }
}
__device__ __forceinline__ void flag_wait(unsigned* bar, int word, unsigned n, int tid) {
    if (tid == 0) { XB_SPIN(xb_ld(&bar[word]) < n, bar); __builtin_amdgcn_fence(__ATOMIC_ACQUIRE, "agent"); asm volatile("s_waitcnt vmcnt(0)" ::: "memory");     }
    __syncthreads();
}

struct Args { const float* in[26]; float* out; unsigned char* ws; int ph_lo, ph_hi; };
struct Frame {
    LAS unsigned char* lds;
    int tid, lane, wave, vcu, G;
    int grp, mi; unsigned gph; bool same_l2;
    unsigned char* ws;
    bf16* X; bf16* H16; bf16* HB16; bf16* P16; float* G32; float* EDGE; float* MOD;
};
__device__ __forceinline__ int grow(const Frame& F, int lr) { return lr < TL ? F.grp * TL + lr : ML + F.grp * TC + (lr - TL); }
__device__ __forceinline__ bf16* wb_ptr(const Frame& F, int layer, size_t off) { return (bf16*)(F.ws + WS_WB + (size_t)layer * WB_LAYER + off); }

__device__ __forceinline__ void p0_transpose_item(const float* W, int K, int N, bf16* WT, int k0, int n0, int drow0, LAS float* scr, int lane) {
    float wv[32];
#pragma unroll
    for (int i = 0; i < 32; ++i) { const int kk = 2 * i + (lane >> 5); wv[i] = W[(size_t)(k0 + kk) * N + n0 + (lane & 31)]; }
#pragma unroll
    for (int i = 0; i < 32; ++i) { const int kk = 2 * i + (lane >> 5); scr[kk * 33 + (lane & 31)] = wv[i]; }
    LDS_WAIT(); asm volatile("" ::: "memory");
    const int c = lane & 7;
#pragma unroll
    for (int j = 0; j < 4; ++j) { const int n = (lane >> 3) + 8 * j; const LAS float* s = scr + (8 * c) * 33 + n;
        v4u o; o.x = pk2(s[0 * 33], s[1 * 33]); o.y = pk2(s[2 * 33], s[3 * 33]); o.z = pk2(s[4 * 33], s[5 * 33]); o.w = pk2(s[6 * 33], s[7 * 33]);
        *(GAS v4u*)(WT + (size_t)(drow0 + n) * K + k0 + 8 * c) = o; }
    LDS_WAIT(); asm volatile("" ::: "memory");
}
__device__ __forceinline__ int up_row_map(int n) {
    const int g = n >= FF ? 1 : 0, c = n - g * FF;
    return (c >> 7) * 256 + g * 128 + (c & 127);
}
__device__ __forceinline__ void convert_layer_weights(Frame& F, const Args& A, int layer, int widx, int nw, int part) {
    LAS float* scr = (LAS float*)(F.lds + F.wave * 8704);
    const int kind = layer % 3, j = layer / 3;
    const float* Win = kind == 0 ? A.in[12] + (size_t)j * D * 3104 : (kind == 1 ? A.in[17] : A.in[22]);
    const int Nin = kind == 2 ? 3072 : 3104;
    const float* Wout = kind == 0 ? A.in[16] + (size_t)j * D * D : (kind == 1 ? A.in[21] : A.in[24]);
    const float* Wup = A.in[8] + (size_t)layer * D * FF2;
    const float* Wdn = A.in[11] + (size_t)layer * FF * D;
    bf16* Tin = wb_ptr(F, layer, WB_IN); bf16* Tout = wb_ptr(F, layer, WB_OUT); bf16* Tup = wb_ptr(F, layer, WB_UP); bf16* Tdn = wb_ptr(F, layer, WB_DN);
    const int nb_in = Nin / 32, I_in = 16 * nb_in, I_out = 16 * 32, I_up = 16 * 176, I_dn = 44 * 32;
    const int NIT = I_in + I_out + I_up + I_dn;
    const int it_lo = part == 2 ? I_in + I_out : 0, it_hi = part == 1 ? I_in + I_out : NIT;
    for (int it = it_lo + widx; it < it_hi; it += nw) {
        int r = it;
        if (r < I_in) { const int kb = r / nb_in, nb = r % nb_in; p0_transpose_item(Win, D, Nin, Tin, 64 * kb, 32 * nb, 32 * nb, scr, F.lane); continue; } r -= I_in;
        if (r < I_out) { const int kb = r / 32, nb = r % 32; p0_transpose_item(Wout, D, D, Tout, 64 * kb, 32 * nb, 32 * nb, scr, F.lane); continue; } r -= I_out;
        if (r < I_up) { const int kb = r / 176, nb = r % 176; p0_transpose_item(Wup, D, FF2, Tup, 64 * kb, 32 * nb, up_row_map(32 * nb), scr, F.lane); continue; } r -= I_up;
        { const int kb = r / 32, nb = r % 32; p0_transpose_item(Wdn, FF, D, Tdn, 64 * kb, 32 * nb, 32 * nb, scr, F.lane); }
    }
    if (kind != 2 && part != 2) {
        const int nz = (NINP - 3104) * D / 8;
        GAS v4u* z = (GAS v4u*)(Tin + (size_t)3104 * D);
        unsigned z_ = 0u; asm volatile("" : "+v"(z_));
        for (int i = widx * 64 + F.lane; i < nz; i += nw * 64) z[i] = (v4u){z_, z_, z_, z_};
    }
}
__device__ __forceinline__ void p0_adaln(Frame& F, const Args& A, int layer, int widx, int nw) {
    LAS float* sv = (LAS float*)(F.lds + 73728);
    LAS float* red = (LAS float*)(F.lds + 73728 + 36864);
    __syncthreads();
    for (int i = F.tid; i < 9 * D; i += NTHR) { const int r = i >> 10, k = i & 1023; const float c = r < 8 ? A.in[1][r * D + k] : A.in[3][k]; sv[i] = siluf_(c); }
    __syncthreads();
    const int col = F.lane & 31, kp = F.lane >> 5;
    for (int task = widx; task < 192; task += nw) {
        const int n0 = task * 32;
        const float* W = A.in[4] + (size_t)layer * D * 6144 + n0 + col;
        float acc[9];
#pragma unroll
        for (int r = 0; r < 9; ++r) acc[r] = 0.f;
        const int kbase = F.wave * 128 + kp;
#pragma unroll
        for (int ib = 0; ib < 2; ++ib) {
            float wv[32];
#pragma unroll
            for (int i = 0; i < 32; ++i) wv[i] = W[(size_t)(kbase + 2 * (ib * 32 + i)) * 6144];
#pragma unroll
            for (int i = 0; i < 32; ++i) { const int k = kbase + 2 * (ib * 32 + i);
#pragma unroll
                for (int r = 0; r < 9; ++r) acc[r] += sv[r * D + k] * wv[i]; }
        }
#pragma unroll
        for (int r = 0; r < 9; ++r) red[((F.wave * 2 + kp) * 9 + r) * 32 + col] = acc[r];
        __syncthreads();
        if (F.tid < 288) { const int r = F.tid >> 5, c2 = F.tid & 31; float s = 0.f;
#pragma unroll
            for (int p2 = 0; p2 < 16; ++p2) s += red[(p2 * 9 + r) * 32 + c2];
            F.MOD[((size_t)layer * 9 + r) * 6144 + n0 + c2] = s + A.in[5][layer * 6144 + n0 + c2]; }
        __syncthreads();
    }
}

__device__ __forceinline__ void norm_phase(Frame& F, const Args& A, int layer, int which, bool first, int nrows, const float* slab, const float* sgate) {
    const int gw = F.mi * NWAVES + F.wave, c0 = F.lane * 16;
    const bool with_ctx = nrows == MT;
    const float* gam = (which == 0 ? A.in[6] : A.in[7]) + layer * D + c0;
    const float* mod = F.MOD + (size_t)layer * 9 * 6144 + (which == 0 ? 0 : 3072) + c0;
    float gv[16];
#pragma unroll
    for (int j = 0; j < 4; ++j) { const f32x4 g = *(const f32x4*)(gam + 4 * j); gv[4 * j] = g.x; gv[4 * j + 1] = g.y; gv[4 * j + 2] = g.z; gv[4 * j + 3] = g.w; }
    {
        float ma[16], mb[16];
        { const float* sh = mod + (size_t)F.grp * 6144; const float* sc = sh + 1024;
#pragma unroll
          for (int j = 0; j < 4; ++j) { const f32x4 a = *(const f32x4*)(sc + 4 * j), bb = *(const f32x4*)(sh + 4 * j);
              ma[4 * j] = gv[4 * j] * (a.x + 1.0f); ma[4 * j + 1] = gv[4 * j + 1] * (a.y + 1.0f); ma[4 * j + 2] = gv[4 * j + 2] * (a.z + 1.0f); ma[4 * j + 3] = gv[4 * j + 3] * (a.w + 1.0f);
              mb[4 * j] = bb.x; mb[4 * j + 1] = bb.y; mb[4 * j + 2] = bb.z; mb[4 * j + 3] = bb.w; } }
#pragma unroll 1
        for (int kb = 0; kb < 8; kb += 4) {
            const int row0 = F.grp * TL + gw + kb * 256;
            if (first) {
                f32x4 xin[4][4];
#pragma unroll
                for (int i = 0; i < 4; ++i)
#pragma unroll
                    for (int j = 0; j < 4; ++j) xin[i][j] = *(const f32x4*)(A.in[0] + (size_t)(row0 + 256 * i) * D + c0 + 4 * j);
#pragma unroll
                for (int i = 0; i < 4; ++i) { const int row = row0 + 256 * i; float x[16];
#pragma unroll
                    for (int j = 0; j < 4; ++j) { x[4 * j] = xin[i][j].x; x[4 * j + 1] = xin[i][j].y; x[4 * j + 2] = xin[i][j].z; x[4 * j + 3] = xin[i][j].w; }
                    float s = 0.f;
#pragma unroll
                    for (int e = 0; e < 16; ++e) s += x[e] * x[e];
                    { bf16* xw = F.X + (size_t)row * D + c0; *(v4u*)xw = pk8(x); *(v4u*)(xw + 8) = pk8(x + 8); }
                    const float rinv = 1.0f / sqrtf(wave_sum(s) * (1.f / D) + EPS);
                    float y[16];
#pragma unroll
                    for (int e = 0; e < 16; ++e) y[e] = x[e] * rinv * ma[e] + mb[e];
                    bf16* hw = F.H16 + (size_t)row * D + c0; *(v4u*)hw = pk8(y); *(v4u*)(hw + 8) = pk8(y + 8); }
            } else {
                v4u xin[4][2];
#pragma unroll
                for (int i = 0; i < 4; ++i) { const bf16* xr = F.X + (size_t)(row0 + 256 * i) * D + c0; xin[i][0] = *(const v4u*)xr; xin[i][1] = *(const v4u*)(xr + 8); }
#pragma unroll
                for (int i = 0; i < 4; ++i) { const int row = row0 + 256 * i; float x[16]; unpk8(xin[i][0], x); unpk8(xin[i][1], x + 8);
                    float s = 0.f;
#pragma unroll
                    for (int e = 0; e < 16; ++e) s += x[e] * x[e];
                    const float rinv = 1.0f / sqrtf(wave_sum(s) * (1.f / D) + EPS);
                    float y[16];
#pragma unroll
                    for (int e = 0; e < 16; ++e) y[e] = x[e] * rinv * ma[e] + mb[e];
                    bf16* hw = F.H16 + (size_t)row * D + c0; *(v4u*)hw = pk8(y); *(v4u*)(hw + 8) = pk8(y + 8); }
            }
        }
    }
    if (with_ctx) {
        const int row = ML + F.grp * TC + gw;
        float x[16];
        if (first) { const float* src = A.in[2] + (size_t)(row - ML) * D + c0;
#pragma unroll
            for (int j = 0; j < 4; ++j) { const f32x4 t = *(const f32x4*)(src + 4 * j); x[4 * j] = t.x; x[4 * j + 1] = t.y; x[4 * j + 2] = t.z; x[4 * j + 3] = t.w; }
        } else { const bf16* xr = F.X + (size_t)row * D + c0; unpk8(*(const v4u*)xr, x); unpk8(*(const v4u*)(xr + 8), x + 8); }
        const bool sl = slab != nullptr;
        if (sl) {
            const bf16* s16 = (const bf16*)slab + (size_t)(row - ML) * D + c0;
#pragma unroll
            for (int hv = 0; hv < 2; ++hv) { float p0[8], p1[8], p2[8], p3[8];
                unpk8(*(const v4u*)(s16 + hv * 8), p0); unpk8(*(const v4u*)(s16 + (size_t)MC * D + hv * 8), p1); unpk8(*(const v4u*)(s16 + (size_t)2 * MC * D + hv * 8), p2); unpk8(*(const v4u*)(s16 + (size_t)3 * MC * D + hv * 8), p3);
                const f32x4 sg0 = *(const f32x4*)(sgate + c0 + hv * 8), sg1 = *(const f32x4*)(sgate + c0 + hv * 8 + 4);
#pragma unroll
                for (int i = 0; i < 8; ++i) x[hv * 8 + i] += (i < 4 ? sg0[i & 3] : sg1[i & 3]) * ((p0[i] + p1[i]) + (p2[i] + p3[i])); }
        }
        float s = 0.f;
#pragma unroll
        for (int i = 0; i < 16; ++i) s += x[i] * x[i];
        if (first || sl) { bf16* xw = F.X + (size_t)row * D + c0; *(v4u*)xw = pk8(x); *(v4u*)(xw + 8) = pk8(x + 8); }
        const float rinv = 1.0f / sqrtf(wave_sum(s) * (1.f / D) + EPS);
        const float* sh = mod + (size_t)8 * 6144; const float* sc = sh + 1024;
        float y[16];
#pragma unroll
        for (int j = 0; j < 4; ++j) { const f32x4 a = *(const f32x4*)(sc + 4 * j), bb = *(const f32x4*)(sh + 4 * j);
            y[4 * j] = x[4 * j] * rinv * gv[4 * j] * (a.x + 1.0f) + bb.x; y[4 * j + 1] = x[4 * j + 1] * rinv * gv[4 * j + 1] * (a.y + 1.0f) + bb.y;
            y[4 * j + 2] = x[4 * j + 2] * rinv * gv[4 * j + 2] * (a.z + 1.0f) + bb.z; y[4 * j + 3] = x[4 * j + 3] * rinv * gv[4 * j + 3] * (a.w + 1.0f) + bb.w; }
        bf16* hw = F.H16 + (size_t)row * D + c0; *(v4u*)hw = pk8(y); *(v4u*)(hw + 8) = pk8(y + 8);
    }
}
__device__ __forceinline__ void final_norm_phase(Frame& F, const Args& A) {
    const int gw = F.mi * NWAVES + F.wave, NGW = 32 * NWAVES, c0 = F.lane * 16;
    float gv[16];
#pragma unroll
    for (int j = 0; j < 4; ++j) { const f32x4 g = *(const f32x4*)(A.in[25] + c0 + 4 * j); gv[4 * j] = g.x; gv[4 * j + 1] = g.y; gv[4 * j + 2] = g.z; gv[4 * j + 3] = g.w; }
    for (int rowA = gw; rowA < TL; rowA += 2 * NGW) {
        const bool vB = rowA + NGW < TL;
        const bf16* xa = F.X + (size_t)(F.grp * TL + rowA) * D + c0; const bf16* xb = F.X + (size_t)(F.grp * TL + (vB ? rowA + NGW : rowA)) * D + c0;
        const v4u a0 = *(const v4u*)xa, a1 = *(const v4u*)(xa + 8), b0 = *(const v4u*)xb, b1 = *(const v4u*)(xb + 8);
#pragma unroll
        for (int q = 0; q < 2; ++q) {
            if (q == 1 && !vB) break;
            const int row = F.grp * TL + rowA + q * NGW;
            float x[16]; unpk8(q == 0 ? a0 : b0, x); unpk8(q == 0 ? a1 : b1, x + 8);
            float s = 0.f;
#pragma unroll
            for (int i = 0; i < 16; ++i) s += x[i] * x[i];
            const float rinv = 1.0f / sqrtf(wave_sum(s) * (1.f / D) + EPS);
#pragma unroll
            for (int j = 0; j < 4; ++j) *(f32x4*)(A.out + (size_t)row * D + c0 + 4 * j) = (f32x4){x[4 * j] * rinv * gv[4 * j], x[4 * j + 1] * rinv * gv[4 * j + 1], x[4 * j + 2] * rinv * gv[4 * j + 2], x[4 * j + 3] * rinv * gv[4 * j + 3]};
        }
    }
}

struct EpiInproj {
    static constexpr bool PERM = true, AFTER_DRAIN = false;
    bf16* P; float* G;
    __device__ __forceinline__ void operator()(const f32x4 (&acc)[2][2][4][2], const pg8::Unit& u, int wr, int wc, int fr, int fq) const {
        const int row0 = u.pm * 256 + wr * 64 + fr;
        if (u.pn < 12) {
            const int col0 = u.pn * 256 + wc * 32 + 8 * fq;
#pragma unroll
            for (int ai = 0; ai < 2; ++ai)
#pragma unroll
                for (int m = 0; m < 4; ++m) { bf16* rowp = P + (size_t)(row0 + ai * 128 + m * 16) * PLD + col0;
#pragma unroll
                    for (int bj = 0; bj < 2; ++bj) { const f32x4 v0 = acc[ai][bj][m][0], v1 = acc[ai][bj][m][1];
                        const v4u w = cvt8_st(v0[0], v0[1], v0[2], v0[3], v1[0], v1[1], v1[2], v1[3]);
                        *(v4u*)(rowp + bj * 128) = w; } }
        } else if (wc == 0) {
#pragma unroll
            for (int ai = 0; ai < 2; ++ai)
#pragma unroll
                for (int m = 0; m < 4; ++m) { float* rowp = G + (size_t)(row0 + ai * 128 + m * 16) * 32 + 8 * fq;
                    *(f32x4*)(rowp) = acc[ai][0][m][0]; *(f32x4*)(rowp + 4) = acc[ai][0][m][1]; }
        }
    }
};
struct EpiResid {
    static constexpr bool PERM = false, AFTER_DRAIN = false;
    float* X; const float* gate;
    __device__ __forceinline__ void operator()(const f32x4 (&acc)[2][2][4][2], const pg8::Unit& u, int wr, int wc, int fr, int fq) const {
        const int row0 = u.pm * 256 + wr * 64 + fr, col0 = u.pn * 256 + wc * 32 + 4 * fq;
        const int r = u.pm < 64 ? (u.pm >> 3) : 8;
        const float* gp = gate + (size_t)r * 6144 + col0;
        f32x4 gv[2][2];
#pragma unroll
        for (int bj = 0; bj < 2; ++bj)
#pragma unroll
            for (int n = 0; n < 2; ++n) gv[bj][n] = *(const f32x4*)(gp + bj * 128 + n * 16);
#pragma unroll
        for (int ai = 0; ai < 2; ++ai)
#pragma unroll
            for (int m = 0; m < 4; ++m) { float* rowp = X + (size_t)(row0 + ai * 128 + m * 16) * D + col0;
#pragma unroll
                for (int bj = 0; bj < 2; ++bj)
#pragma unroll
                    for (int n = 0; n < 2; ++n) { float* p = rowp + bj * 128 + n * 16; *(f32x4*)p = *(const f32x4*)p + gv[bj][n] * acc[ai][bj][m][n]; } }
    }
};
struct GroupOrder {
    int g, mi, npan, nN, ntK, wid;
    __device__ bool next(int i, pg8::Unit& u) const {
        const int L = i * 32 + mi; if (L >= npan * nN) return false;
        const int pcol = L / npan, p = L - pcol * npan;
        u.pm = p < 8 ? g * 8 + p : 64 + g; u.pn = pcol; u.k0 = 0; u.nt = ntK; return true;
    }
    __device__ __forceinline__ void a_ready(const pg8::Unit&) const {}
    __device__ __forceinline__ void done(const pg8::Unit&) const {}
};
struct GroupSplitOrder {
    int g, mi, ntK, np, wid;
    __device__ bool next(int i, pg8::Unit& u) const {
        const bool piece = mi < np;
        if (piece && i == 0) { const int q = mi & 3; u.pm = 64 + g; u.pn = mi >> 2;
            if (ntK == 16) { u.k0 = q * 256; u.nt = 4; } else { u.k0 = (q < 2 ? q * 10 : 20 + (q - 2) * 12) * 64; u.nt = q < 2 ? 10 : 12; }
            return true; }
        if (i == (piece ? 1 : 0)) { u.pm = g * 8 + (mi & 7); u.pn = mi >> 3; u.k0 = 0; u.nt = ntK; return true; }
        return false;
    }
    __device__ __forceinline__ void a_ready(const pg8::Unit&) const {}
    __device__ __forceinline__ void done(const pg8::Unit&) const {}
};
struct SplitOrder {
    pg8::StaticOrder lat; int G, c, ntK, np, wid;
    __device__ void init(int K, int G_, int c_, bool with_ctx) { lat.init(ML, D, G_, c_); lat.ntK = K / 64; G = G_; c = c_; ntK = K / 64; np = with_ctx ? 128 : 0; }
    __device__ bool next(int i, pg8::Unit& u) const {
        if (G == 256) {
            if (c < np) { if (i == 0) {   } else if (i == 1) return lat.next(0, u); else return false; }
            else return i == 0 ? lat.next(0, u) : false;
        }
        const int L = G == 256 ? 256 + c : i * G + c;
        if (L < 256) return lat.next(i, u);
        const int piece = L - 256; if (piece >= np) return false;
        const int unit = piece >> 2, q = piece & 3;
        u.pm = 64 + (unit >> 2); u.pn = unit & 3;
        if (ntK == 16) { u.k0 = q * 256; u.nt = 4; }
        else { u.k0 = (q < 2 ? q * 10 : 20 + (q - 2) * 12) * 64; u.nt = q < 2 ? 10 : 12; }
        return true;
    }
    __device__ __forceinline__ void a_ready(const pg8::Unit&) const {}
    __device__ __forceinline__ void done(const pg8::Unit&) const {}
};
struct EpiResidSplit {
    static constexpr bool PERM = true, AFTER_DRAIN = false;
    bf16* X; const float* gate; float* SLAB; int dry;
    __device__ __forceinline__ void operator()(const f32x4 (&acc)[2][2][4][2], const pg8::Unit& u, int wr, int wc, int fr, int fq) const {
        const int row0 = u.pm * 256 + wr * 64 + fr, col0 = u.pn * 256 + wc * 32 + 8 * fq;
        if (u.pm < 64) {
            if (dry) return;
            const float* gp = gate + (size_t)(u.pm >> 3) * 6144 + col0;
            f32x4 g0[2], g1[2];
#pragma unroll
            for (int bj = 0; bj < 2; ++bj) { g0[bj] = *(const f32x4*)(gp + bj * 128); g1[bj] = *(const f32x4*)(gp + bj * 128 + 4); }
#pragma unroll
            for (int ai = 0; ai < 2; ++ai)
#pragma unroll
                for (int m = 0; m < 4; ++m) { bf16* rowp = X + (size_t)(row0 + ai * 128 + m * 16) * D + col0;
#pragma unroll
                    for (int bj = 0; bj < 2; ++bj) { bf16* pp = rowp + bj * 128; const v4u xo = *(const v4u*)pp;
                        const f32x4 x0 = (f32x4){bflo(xo.x), bfhi(xo.x), bflo(xo.y), bfhi(xo.y)} + g0[bj] * acc[ai][bj][m][0];
                        const f32x4 x1 = (f32x4){bflo(xo.z), bfhi(xo.z), bflo(xo.w), bfhi(xo.w)} + g1[bj] * acc[ai][bj][m][1];
                        const v4u w = cvt8_st(x0[0], x0[1], x0[2], x0[3], x1[0], x1[1], x1[2], x1[3]);
                        *(v4u*)pp = w; } }
        } else {
            const int q = u.nt == 4 ? (u.k0 >> 8) : (u.k0 < 1280 ? u.k0 / 640 : 2 + (u.k0 - 1280) / 768);
            bf16* sb = (bf16*)SLAB + (size_t)q * MC * D;
#pragma unroll
            for (int ai = 0; ai < 2; ++ai)
#pragma unroll
                for (int m = 0; m < 4; ++m) { bf16* rowp = sb + (size_t)(row0 - ML + ai * 128 + m * 16) * D + col0;
#pragma unroll
                    for (int bj = 0; bj < 2; ++bj) { const f32x4 v0 = acc[ai][bj][m][0], v1 = acc[ai][bj][m][1];
                        const v4u w = cvt8_st(v0[0], v0[1], v0[2], v0[3], v1[0], v1[1], v1[2], v1[3]);
                        *(v4u*)(rowp + bj * 128) = w; } }
        }
    }
};
struct EpiConvGate {
    static constexpr bool PERM = false, AFTER_DRAIN = false;
    bf16* ACT; float* EDGE; const float* cw; const float* cb; LAS float* ce;
    __device__ __forceinline__ void operator()(const f32x4 (&acc)[2][2][4][2], const pg8::Unit& u, int wr, int wc, int fr, int fq) const {
        const int lane = fq * 16 + fr;
        float pw[2][8];
#pragma unroll
        for (int n = 0; n < 2; ++n) { const int c = u.pn * 128 + wc * 32 + n * 16 + fr;
            pw[n][0] = cw[c]; pw[n][1] = cw[FF2 + c]; pw[n][2] = cw[2 * FF2 + c]; pw[n][3] = cb[c];
            pw[n][4] = cw[FF + c]; pw[n][5] = cw[FF2 + FF + c]; pw[n][6] = cw[2 * FF2 + FF + c]; pw[n][7] = cb[FF + c]; }
#pragma unroll
        for (int ai = 0; ai < 2; ++ai) { const int blk = ai * 2 + wr;
#pragma unroll
            for (int bj = 0; bj < 2; ++bj)
#pragma unroll
                for (int n = 0; n < 2; ++n) { const int col = bj * 128 + wc * 32 + n * 16 + fr;
                    if (fq == 0) ce[(blk * 2 + 0) * 256 + col] = acc[ai][bj][0][n][0];
                    if (fq == 3) ce[(blk * 2 + 1) * 256 + col] = acc[ai][bj][3][n][3]; } }
        {
            float* eb = EDGE + (size_t)u.pm * 4 * FF2 + u.pn * 256;
#pragma unroll
            for (int bj = 0; bj < 2; ++bj)
#pragma unroll
                for (int n = 0; n < 2; ++n) { const int col = bj * 128 + wc * 32 + n * 16 + fr;
                    if (wr == 0 && fq == 0) { eb[0 * FF2 + col] = acc[0][bj][0][n][0]; eb[1 * FF2 + col] = acc[0][bj][0][n][1]; }
                    if (wr == 1 && fq == 3) { eb[2 * FF2 + col] = acc[1][bj][3][n][2]; eb[3 * FF2 + col] = acc[1][bj][3][n][3]; } }
        }
        asm volatile("s_waitcnt lgkmcnt(0)" ::: "memory"); __builtin_amdgcn_s_barrier(); asm volatile("" ::: "memory");
        const int upl = (lane + 48) & 63, dnl = (lane + 16) & 63;
        bf16* tb = ACT + (size_t)u.pm * 256 * FF + u.pn * 128;
        bf16* tb1 = tb + FF; bf16* tb2 = tb + 2 * FF; bf16* tb3 = tb + 3 * FF;
#pragma unroll
        for (int n = 0; n < 2; ++n) {
            const int c = u.pn * 128 + wc * 32 + n * 16 + fr;
            const float kg = -1.4426950408889634f, ka = -0.6931471805599453f;
            const float wa0 = pw[n][0] * ka, wa1 = pw[n][1] * ka, wa2 = pw[n][2] * ka, ba = pw[n][3] * ka;
            const float wg0 = pw[n][4] * kg, wg1 = pw[n][5] * kg, wg2 = pw[n][6] * kg, bg = pw[n][7] * kg;
#pragma unroll
            for (int ai = 0; ai < 2; ++ai) {
                const int blk = ai * 2 + wr;
                const int cola = wc * 32 + n * 16 + fr, colg = 128 + cola;
                const float epa = blk > 0 ? ce[((blk - 1) * 2 + 1) * 256 + cola] : 0.f, epg = blk > 0 ? ce[((blk - 1) * 2 + 1) * 256 + colg] : 0.f;
                const float ena = blk < 3 ? ce[((blk + 1) * 2 + 0) * 256 + cola] : 0.f, eng = blk < 3 ? ce[((blk + 1) * 2 + 0) * 256 + colg] : 0.f;
                float sUa[4], sDa[4], sUg[4], sDg[4];
#pragma unroll
                for (int m = 0; m < 4; ++m) { sUa[m] = __shfl(acc[ai][0][m][n][3], upl); sDa[m] = __shfl(acc[ai][0][m][n][0], dnl);
                                              sUg[m] = __shfl(acc[ai][1][m][n][3], upl); sDg[m] = __shfl(acc[ai][1][m][n][0], dnl); }
#pragma unroll
                for (int m = 0; m < 4; ++m) {
                    const f32x4 xa = acc[ai][0][m][n], xg = acc[ai][1][m][n];
                    const float pa = fq > 0 ? sUa[m] : (m > 0 ? sUa[m > 0 ? m - 1 : 0] : epa), pg = fq > 0 ? sUg[m] : (m > 0 ? sUg[m > 0 ? m - 1 : 0] : epg);
                    const float na = fq < 3 ? sDa[m] : (m < 3 ? sDa[m < 3 ? m + 1 : 3] : ena), ng = fq < 3 ? sDg[m] : (m < 3 ? sDg[m < 3 ? m + 1 : 3] : eng);
                    const float a0 = fmaf(wa0, pa,    fmaf(wa1, xa[0], fmaf(wa2, xa[1], ba))), g0 = fmaf(wg0, pg,    fmaf(wg1, xg[0], fmaf(wg2, xg[1], bg)));
                    const float a1 = fmaf(wa0, xa[0], fmaf(wa1, xa[1], fmaf(wa2, xa[2], ba))), g1 = fmaf(wg0, xg[0], fmaf(wg1, xg[1], fmaf(wg2, xg[2], bg)));
                    const float a2 = fmaf(wa0, xa[1], fmaf(wa1, xa[2], fmaf(wa2, xa[3], ba))), g2 = fmaf(wg0, xg[1], fmaf(wg1, xg[2], fmaf(wg2, xg[3], bg)));
                    const float a3 = fmaf(wa0, xa[2], fmaf(wa1, xa[3], fmaf(wa2, na,    ba))), g3 = fmaf(wg0, xg[2], fmaf(wg1, xg[3], fmaf(wg2, ng,    bg)));
                    const float y0 = (a0 * g0) * __builtin_amdgcn_rcpf(1.0f + __builtin_amdgcn_exp2f(g0)), y1 = (a1 * g1) * __builtin_amdgcn_rcpf(1.0f + __builtin_amdgcn_exp2f(g1));
                    const float y2 = (a2 * g2) * __builtin_amdgcn_rcpf(1.0f + __builtin_amdgcn_exp2f(g2)), y3 = (a3 * g3) * __builtin_amdgcn_rcpf(1.0f + __builtin_amdgcn_exp2f(g3));
                    const unsigned ob = ((unsigned)(ai * 128 + wr * 64 + m * 16 + 4 * fq) * FF + (unsigned)(wc * 32 + n * 16 + fr)) * 2u;
                    const unsigned p01 = cvtpk(y0, y1), p23 = cvtpk(y2, y3);
                    asm volatile("global_store_short %0, %1, %2" :: "v"(ob), "v"(p01), "s"(tb) : "memory");
                    asm volatile("global_store_short_d16_hi %0, %1, %2" :: "v"(ob), "v"(p01), "s"(tb1) : "memory");
                    asm volatile("global_store_short %0, %1, %2" :: "v"(ob), "v"(p23), "s"(tb2) : "memory");
                    asm volatile("global_store_short_d16_hi %0, %1, %2" :: "v"(ob), "v"(p23), "s"(tb3) : "memory");
                }
            }
        }
        asm volatile("s_waitcnt lgkmcnt(0)" ::: "memory"); __builtin_amdgcn_s_barrier(); asm volatile("" ::: "memory");
    }
};
__device__ __forceinline__ void ffn_fixup_phase(Frame& F, const Args& A, int layer) {
    bf16* ACT = F.P16;
    const float* cw = A.in[9] + (size_t)layer * 3 * FF2; const float* cb = A.in[10] + (size_t)layer * FF2;
    for (int task = 14 * F.grp + F.mi; task < 14 * F.grp + 14; task += 32) {
        const int bnd = task >> 1, lower = task & 1;
        const int pmA = (bnd / 7) * 8 + (bnd % 7);
        const float* eA = F.EDGE + (size_t)pmA * 4 * FF2; const float* eB = eA + 4 * FF2;
        const float* rp = lower ? eA + 3 * FF2 : eA + 2 * FF2;
        const float* rc = lower ? eB + 0 * FF2 : eA + 3 * FF2;
        const float* rn = lower ? eB + 1 * FF2 : eB + 0 * FF2;
        const int row = lower ? (pmA + 1) * 256 : pmA * 256 + 255;
        for (int c = F.tid; c < FF; c += NTHR) {
            const int ea = (c >> 7) * 256 + (c & 127), eg = ea + 128;
            const float a = cw[c] * rp[ea] + cw[FF2 + c] * rc[ea] + cw[2 * FF2 + c] * rn[ea] + cb[c];
            const float g = cw[FF + c] * rp[eg] + cw[FF2 + FF + c] * rc[eg] + cw[2 * FF2 + FF + c] * rn[eg] + cb[FF + c];
            ACT[(size_t)row * FF + c] = (bf16)f2bf(a * siluf_(g));
        }
    }
}

#define MFMA16(a, b, c) __builtin_amdgcn_mfma_f32_16x16x32_bf16((a), (b), (c), 0, 0, 0)
__device__ __forceinline__ bf16x8 cvt8_mma(float a0, float a1, float a2, float a3, float a4, float a5, float a6, float a7) {
    v4u p;
    asm volatile("s_nop 0\n\tv_cvt_pk_bf16_f32 %0, %4, %5\n\tv_cvt_pk_bf16_f32 %1, %6, %7\n\tv_cvt_pk_bf16_f32 %2, %8, %9\n\tv_cvt_pk_bf16_f32 %3, %10, %11\n\ts_nop 1"
                 : "=&v"(p.x), "=&v"(p.y), "=&v"(p.z), "=&v"(p.w) : "v"(a0), "v"(a1), "v"(a2), "v"(a3), "v"(a4), "v"(a5), "v"(a6), "v"(a7));
    return __builtin_bit_cast(bf16x8, p);
}
#define PIN2(a, b) asm volatile("" : "+v"(a), "+v"(b))
#define PIN4(a, b, c, d) asm volatile("" : "+v"(a), "+v"(b), "+v"(c), "+v"(d))
#define PIN5(a, b, c, d, e) asm volatile("" : "+v"(a), "+v"(b), "+v"(c), "+v"(d), "+v"(e))
#define PIN8(a, b, c, d, e, f, g, h) asm volatile("" : "+v"(a), "+v"(b), "+v"(c), "+v"(d), "+v"(e), "+v"(f), "+v"(g), "+v"(h))
__device__ __forceinline__ bf16x8 ldfrag(const LAS bf16* base, int ld, int r0, int k0, int lane) {
    return *(const LAS bf16x8*)(base + (r0 + (lane & 15)) * ld + k0 + 8 * (lane >> 4));
}
__device__ __forceinline__ void unpack8(const v4u w, float* f) {
    f[0] = bflo(w.x); f[1] = bfhi(w.x); f[2] = bflo(w.y); f[3] = bfhi(w.y); f[4] = bflo(w.z); f[5] = bfhi(w.z); f[6] = bflo(w.w); f[7] = bfhi(w.w);
}
__device__ __forceinline__ v4u pack8(const float* f) { v4u w; w.x = pk2(f[0], f[1]); w.y = pk2(f[2], f[3]); w.z = pk2(f[4], f[5]); w.w = pk2(f[6], f[7]); return w; }

typedef short s16x4 __attribute__((ext_vector_type(4)));
__device__ __forceinline__ bf16x8 ldfrag_tr(const LAS bf16* base, int ld, int k0, int c0, int lane) {
    const int i = lane & 15, kq = lane >> 4;
    const LAS bf16* p = base + (k0 + 8 * kq + (i >> 2)) * ld + c0 + 4 * (i & 3);
    const s16x4 lo = __builtin_amdgcn_ds_read_tr16_b64_v4i16((LAS s16x4*)p);
    const s16x4 hi = __builtin_amdgcn_ds_read_tr16_b64_v4i16((LAS s16x4*)(p + 4 * ld));
    return (bf16x8){lo.x, lo.y, lo.z, lo.w, hi.x, hi.y, hi.z, hi.w};
}
__device__ __forceinline__ bf16x8 ldfrag_tr4(const LAS bf16* base, int ld, int s0, int c0, int lane) {
    const int i = lane & 15, kq = lane >> 4;
    const LAS bf16* p = base + (s0 + 4 * kq + (i >> 2)) * ld + c0 + 4 * (i & 3);
    const s16x4 lo = __builtin_amdgcn_ds_read_tr16_b64_v4i16((LAS s16x4*)p);
    const s16x4 hi = __builtin_amdgcn_ds_read_tr16_b64_v4i16((LAS s16x4*)(p + 16 * ld));
    return (bf16x8){lo.x, lo.y, lo.z, lo.w, hi.x, hi.y, hi.z, hi.w};
}
__device__ __forceinline__ void mlstm_prep_phase(Frame& F, const Args& A, int jk, bf16* QKl, bf16* QKc) {
    const float* convw = A.in[14] + (size_t)jk * 3 * 1024; const float* convb = A.in[15] + (size_t)jk * 1024;
    const int gw = F.mi * NWAVES + F.wave, NGW = 32 * NWAVES, lane = F.lane;
    for (int task = gw; task < 576; task += NGW) {
        const int half = task & 1, row0 = grow(F, (task >> 1) * 8);
        const bool lat = row0 < ML;
        const int tpos = lat ? (row0 & (TL - 1)) : ((row0 - ML) & (TC - 1)), Tn = lat ? TL : TC;
        const int c0 = half * 512 + lane * 8;
        float w0[8], w1[8], w2[8], bb[8];
#pragma unroll
        for (int i = 0; i < 8; ++i) { w0[i] = convw[c0 + i]; w1[i] = convw[1024 + c0 + i]; w2[i] = convw[2048 + c0 + i]; bb[i] = convb[c0 + i]; }
        const float sc = half == 0 ? 0.125f : 1.0f;
        const bf16* src = F.P16 + (size_t)row0 * PLD + c0;
        bf16* dst = (lat ? QKl + (size_t)row0 * D : QKc + (size_t)(row0 - ML) * D) + c0;
        v4u xr[10];
#pragma unroll
        for (int i = 0; i < 10; ++i) { const int tp = tpos - 1 + i; xr[i] = (tp >= 0 && tp < Tn) ? *(const v4u*)(src + (ptrdiff_t)(i - 1) * PLD) : (v4u){0u, 0u, 0u, 0u}; }
#pragma unroll
        for (int t = 0; t < 8; ++t) {
            float xp[8], xc[8], xn[8], y[8];
            unpack8(xr[t], xp); unpack8(xr[t + 1], xc); unpack8(xr[t + 2], xn);
#pragma unroll
            for (int i = 0; i < 8; ++i) y[i] = siluf_(w0[i] * xp[i] + w1[i] * xc[i] + w2[i] * xn[i] + bb[i]) * sc;
            *(v4u*)(dst + (size_t)t * D) = pack8(y);
        }
    }
}
__device__ __forceinline__ void mlstm_phase(Frame& F, const Args& A, int jk, const bf16* QKl, const bf16* QKc, f32x4* GJ) {
    LAS float* ga = (LAS float*)(F.lds + 57344);
    LAS float* aa = (LAS float*)(F.lds + 57344 + 9216);
    LAS float* cma = (LAS float*)(F.lds + 57344 + 18432);
    LAS float* scl = (LAS float*)(F.lds + 137728);
    const float* bgate = A.in[13] + jk * 32;
    const int tid = F.tid, lane = F.lane, wave = F.wave, fr = lane & 15, fq = lane >> 4;
    for (int task = F.vcu; task < 256; task += F.G) {
        const int eh = task & 1, dir = (task >> 1) & 1, h = (task >> 2) & 7, b = task >> 5;
        const int e0 = eh * 64;
        bf16* Hout = dir == 0 ? F.H16 : F.HB16;
        f32x4* gj = GJ + (size_t)task * 2304;
        __syncthreads();
        for (int i = tid; i < 80 * 72 / 2; i += NTHR) ((LAS unsigned*)(F.lds + 114688))[i] = 0u;
        if (tid < 256) { unsigned z_ = 0u; asm volatile("" : "+v"(z_));
            LAS v4u* p = (LAS v4u*)(F.lds + (tid >> 7) * 57344 + 36864 + ((tid & 127) * 80 + 64) * 2); p[0] = (v4u){0x3F80u | z_, z_, z_, z_}; p[1] = (v4u){z_, z_, z_, z_}; }
        {
            const float bi = bgate[(2 * dir) * 8 + h], bfg = bgate[(2 * dir + 1) * 8 + h];
            for (int c = wave; c < 18; c += 8) {
                const bool isctx = c < 2; const int cc = isctx ? c : c - 2; const int Tn = isctx ? TC : TL;
                const int rowbase = isctx ? ML + b * TC : b * TL;
                const int t0 = dir == 0 ? cc * 128 : Tn - 128 * (cc + 1);
                const int j0 = 2 * lane, p0 = dir == 0 ? t0 + j0 : t0 + 127 - j0, p1 = dir == 0 ? p0 + 1 : p0 - 1;
                const float* g0p = F.G32 + (size_t)(rowbase + p0) * 32; const float* g1p = F.G32 + (size_t)(rowbase + p1) * 32;
                const float ig0 = g0p[(2 * dir) * 8 + h] + bi, lf0 = logsigmoidf_(g0p[(2 * dir + 1) * 8 + h] + bfg);
                const float ig1 = g1p[(2 * dir) * 8 + h] + bi, lf1 = logsigmoidf_(g1p[(2 * dir + 1) * 8 + h] + bfg);
                float sum = lf0 + lf1;
#pragma unroll
                for (int o = 1; o < 64; o <<= 1) { const float t = __shfl_up(sum, o); if (lane >= o) sum += t; }
                const float gg0 = sum - lf1, gg1 = sum;
                const float a0 = ig0 - gg0, a1 = ig1 - gg1;
                float mx = fmaxf(a0, a1);
#pragma unroll
                for (int o = 1; o < 64; o <<= 1) { const float t = __shfl_up(mx, o); if (lane >= o) mx = fmaxf(mx, t); }
                float ex = __shfl_up(mx, 1); if (lane == 0) ex = -INFINITY;
                const float c0v = fmaxf(ex, a0), c1v = mx;
                ga[c * 128 + j0] = gg0; ga[c * 128 + j0 + 1] = gg1; aa[c * 128 + j0] = a0; aa[c * 128 + j0 + 1] = a1; cma[c * 128 + j0] = c0v; cma[c * 128 + j0 + 1] = c1v;
                if (lane == 63) { scl[c] = gg1; scl[32 + c] = c1v; }
            }
        }
        __syncthreads();
        if (tid == 0) { float m = 0.f;
            for (int c = 0; c < 18; ++c) { const float gL = scl[c], cmL = scl[32 + c], mn = gL + fmaxf(m, cmL); scl[64 + c] = m; scl[96 + c] = __expf(gL + m - mn); scl[128 + c] = __expf(gL + cmL - mn); m = mn; } }
        __syncthreads();
        for (int idx = tid; idx < 2304; idx += NTHR) { const int c = idx >> 7; const float mc = scl[64 + c], cmL = scl[32 + c], mxj = fmaxf(cma[idx], mc);
            gj[idx] = (f32x4){__expf(aa[idx] - cmL), __expf(cmL - mxj), __expf(mc - mxj), __expf(-(ga[idx] + mxj))}; }
        asm volatile("s_waitcnt vmcnt(0)" ::: "memory");
        __syncthreads();
        f32x4 st[5];
#pragma unroll
        for (int k = 0; k < 5; ++k) st[k] = (f32x4){0.f, 0.f, 0.f, 0.f};
        const int nst = wave < 2 ? 5 : (wave < 4 ? 3 : (wave < 6 ? 2 : 0));
        const int st0i = wave < 2 ? wave * 5 : (wave < 4 ? 10 + (wave - 2) * 3 : 16 + (wave - 4) * 2);
        const int s = tid >> 2, cg = tid & 3, jt = wave;
        v4u rq0, rq1, rk0, rk1, rv0, rv1; float e1n; f32x4 jn;
#define MLSTM_LOAD(stepn) do { const bool ic_ = (stepn) < 2; const int c_ = ic_ ? (stepn) : (stepn) - 2, Tn_ = ic_ ? TC : TL; \
            const int t0_ = dir == 0 ? c_ * 128 : Tn_ - 128 * (c_ + 1), pos_ = dir == 0 ? t0_ + s : t0_ + 127 - s; \
            const bf16* qk_ = ic_ ? QKc + (size_t)(b * TC + pos_) * D : QKl + (size_t)(b * TL + pos_) * D; \
            const bf16* pv_ = F.P16 + (size_t)((ic_ ? ML + b * TC : b * TL) + pos_) * PLD + 1024 + h * 128 + e0 + cg * 16; \
            rq0 = *(const v4u*)(qk_ + h * 64 + cg * 16); rq1 = *(const v4u*)(qk_ + h * 64 + cg * 16 + 8); \
            rk0 = *(const v4u*)(qk_ + 512 + h * 64 + cg * 16); rk1 = *(const v4u*)(qk_ + 512 + h * 64 + cg * 16 + 8); \
            rv0 = *(const v4u*)(pv_); rv1 = *(const v4u*)(pv_ + 8); \
            e1n = ((const float*)(gj + (stepn) * 128 + s))[0]; jn = gj[(stepn) * 128 + 16 * jt + fr]; } while (0)
        MLSTM_LOAD(0);
        for (int step = 0; step < 18; ++step) {
            const int p = step & 1;
            LAS bf16* Qs = (LAS bf16*)(F.lds + p * 57344);
            LAS bf16* Kw = (LAS bf16*)(F.lds + p * 57344 + 18432);
            LAS bf16* Vs = (LAS bf16*)(F.lds + p * 57344 + 36864);
            const LAS bf16* CTr = (const LAS bf16*)(F.lds + 114688 + p * 11520);
            LAS bf16* CTw = (LAS bf16*)(F.lds + 114688 + (p ^ 1) * 11520);
            const bool isctx = step < 2; const int c = isctx ? step : step - 2; const int Tn = isctx ? TC : TL;
            const int rowbase = isctx ? ML + b * TC : b * TL;
            const int t0 = dir == 0 ? c * 128 : Tn - 128 * (c + 1);
            {
                *(LAS v4u*)(Qs + s * 72 + cg * 16) = rq0; *(LAS v4u*)(Qs + s * 72 + cg * 16 + 8) = rq1;
                float kf[16]; unpack8(rk0, kf); unpack8(rk1, kf + 8);
#pragma unroll
                for (int i = 0; i < 16; ++i) kf[i] *= e1n;
                v4u w0, w1; w0.x = pg8::cvt_pk_bf16(kf[0], kf[1]); w0.y = pg8::cvt_pk_bf16(kf[2], kf[3]); w0.z = pg8::cvt_pk_bf16(kf[4], kf[5]); w0.w = pg8::cvt_pk_bf16(kf[6], kf[7]);
                w1.x = pg8::cvt_pk_bf16(kf[8], kf[9]); w1.y = pg8::cvt_pk_bf16(kf[10], kf[11]); w1.z = pg8::cvt_pk_bf16(kf[12], kf[13]); w1.w = pg8::cvt_pk_bf16(kf[14], kf[15]);
                *(LAS v4u*)(Kw + s * 72 + cg * 16) = w0; *(LAS v4u*)(Kw + s * 72 + cg * 16 + 8) = w1;
                *(LAS v4u*)(Vs + s * 80 + cg * 16) = rv0; *(LAS v4u*)(Vs + s * 80 + cg * 16 + 8) = rv1;
            }
            const float e2 = jn.y, itr = jn.z, enm = jn.w;
            if (step + 1 < 18) MLSTM_LOAD(step + 1);
            asm volatile("s_waitcnt lgkmcnt(0)" ::: "memory"); __builtin_amdgcn_s_barrier(); asm volatile("" ::: "memory");
            {
                bf16x8 qb0 = ldfrag(Qs, 72, 16 * jt, 0, lane), qb1 = ldfrag(Qs, 72, 16 * jt, 32, lane);
                f32x4 nT[5];
#pragma unroll
                for (int et = 0; et < 5; ++et) nT[et] = (f32x4){0.f, 0.f, 0.f, 0.f};
                for (int sp = 0; sp <= (jt >> 1); ++sp) {
                    const int ts0 = 2 * sp, ts1 = 2 * sp + 1;
                    bf16x8 k0a = ldfrag(Kw, 72, 16 * ts0, 0, lane), k0b = ldfrag(Kw, 72, 16 * ts0, 32, lane), k1a = ldfrag(Kw, 72, 16 * ts1, 0, lane), k1b = ldfrag(Kw, 72, 16 * ts1, 32, lane);
                    bf16x8 vf[5];
#pragma unroll
                    for (int et = 0; et < 5; ++et) vf[et] = ldfrag_tr4(Vs, 80, 32 * sp, 16 * et, lane);
                    PIN2(qb0, qb1); PIN4(k0a, k0b, k1a, k1b); PIN5(vf[0], vf[1], vf[2], vf[3], vf[4]);
                    f32x4 sT0 = {0.f, 0.f, 0.f, 0.f}, sT1 = sT0, sT2 = sT0, sT3 = sT0;
                    sT0 = MFMA16(k0a, qb0, sT0); sT1 = MFMA16(k1a, qb0, sT1); sT2 = MFMA16(k0b, qb1, sT2); sT3 = MFMA16(k1b, qb1, sT3);
                    sT0 = sT0 + sT2; sT1 = sT1 + sT3;
#pragma unroll
                    for (int reg = 0; reg < 4; ++reg) { const bool v0 = (ts0 < jt) || (4 * fq + reg <= fr), v1 = (ts1 < jt) || (ts1 == jt && 4 * fq + reg <= fr);
                        sT0[reg] = v0 ? sT0[reg] : 0.f; sT1[reg] = v1 ? sT1[reg] : 0.f; }
                    const bf16x8 pf = cvt8_mma(sT0[0], sT0[1], sT0[2], sT0[3], sT1[0], sT1[1], sT1[2], sT1[3]);
#pragma unroll
                    for (int et = 0; et < 5; ++et) nT[et] = MFMA16(vf[et], pf, nT[et]);
                }
                {
                    bf16x8 cf[10];
#pragma unroll
                    for (int et = 0; et < 5; ++et) { cf[2 * et] = ldfrag(CTr, 72, 16 * et, 0, lane); cf[2 * et + 1] = ldfrag(CTr, 72, 16 * et, 32, lane); }
                    PIN5(cf[0], cf[1], cf[2], cf[3], cf[4]); PIN5(cf[5], cf[6], cf[7], cf[8], cf[9]);
                    f32x4 qc[5], qd[5];
#pragma unroll
                    for (int et = 0; et < 5; ++et) { qc[et] = (f32x4){0.f, 0.f, 0.f, 0.f}; qc[et] = MFMA16(cf[2 * et], qb0, qc[et]); }
#pragma unroll
                    for (int et = 0; et < 5; ++et) { qd[et] = (f32x4){0.f, 0.f, 0.f, 0.f}; qd[et] = MFMA16(cf[2 * et + 1], qb1, qd[et]); }
#pragma unroll
                    for (int et = 0; et < 5; ++et) nT[et] = nT[et] * e2 + (qc[et] + qd[et]) * itr;
                }
                const float den = __shfl(nT[4][0], fr);
                const float inv = 1.0f / fmaxf(fabsf(den), enm);
                const int jj = 16 * jt + fr; const int pos = dir == 0 ? t0 + jj : t0 + 127 - jj;
                bf16* op = Hout + (size_t)(rowbase + pos) * D + h * 128 + e0 + 4 * fq;
#pragma unroll
                for (int et = 0; et < 4; ++et) { v2u w; w.x = pg8::cvt_pk_bf16(nT[et][0] * inv, nT[et][1] * inv); w.y = pg8::cvt_pk_bf16(nT[et][2] * inv, nT[et][3] * inv); *(v2u*)(op + 16 * et) = w; }
            }
            {
                const float decay = scl[96 + step], sc2 = scl[128 + step];
#pragma unroll
                for (int k = 0; k < 5; ++k) {
                    if (k < nst) { const int ti = st0i + k, et = ti >> 2, dt = ti & 3;
                        bf16x8 va[4], kb[4];
#pragma unroll
                        for (int ks = 0; ks < 4; ++ks) { va[ks] = ldfrag_tr(Vs, 80, 32 * ks, 16 * et, lane); kb[ks] = ldfrag_tr(Kw, 72, 32 * ks, 16 * dt, lane); }
                        PIN4(va[0], va[1], va[2], va[3]); PIN4(kb[0], kb[1], kb[2], kb[3]);
                        f32x4 t0a = {0.f, 0.f, 0.f, 0.f}, t1a = t0a;
                        t0a = MFMA16(va[0], kb[0], t0a); t1a = MFMA16(va[1], kb[1], t1a); t0a = MFMA16(va[2], kb[2], t0a); t1a = MFMA16(va[3], kb[3], t1a);
                        st[k] = st[k] * decay + (t0a + t1a) * sc2; }
                }
#pragma unroll
                for (int k = 0; k < 5; ++k) {
                    if (k < nst) { const int ti = st0i + k, et = ti >> 2, dt = ti & 3;
#pragma unroll
                        for (int reg = 0; reg < 4; ++reg) CTw[(16 * et + 4 * fq + reg) * 72 + 16 * dt + fr] = (bf16)f2bf(st[k][reg]); }
                }
            }
        }
#undef MLSTM_LOAD
    }
}
__device__ __forceinline__ void mlstm_combine_phase(Frame& F, const Args& A, int nrows) {
    const int gw = F.mi * NWAVES + F.wave, NGW = 32 * NWAVES, nloc = nrows == MT ? TL + TC : TL;
    for (int lr = gw; lr < nloc; lr += NGW) { const int row = grow(F, lr);
        bf16* hf = F.H16 + (size_t)row * D + F.lane * 16; const bf16* hb = F.HB16 + (size_t)row * D + F.lane * 16; const bf16* o = F.P16 + (size_t)row * PLD + 2048 + F.lane * 16;
#pragma unroll
        for (int hv = 0; hv < 2; ++hv) { float a[8], b2[8], g[8], y[8];
            unpack8(*(const v4u*)(hf + hv * 8), a); unpack8(*(const v4u*)(hb + hv * 8), b2); unpack8(*(const v4u*)(o + hv * 8), g);
#pragma unroll
            for (int i = 0; i < 8; ++i) y[i] = (a[i] + b2[i]) * sigmoidf_(g[i]);
            *(v4u*)(hf + hv * 8) = pack8(y); }
    }
}

__device__ __forceinline__ void gla_prep_phase(Frame& F, const Args& A, bf16* QGl, bf16* QGc, float* EGL) {
    const int gw = F.mi * NWAVES + F.wave, NGW = 32 * NWAVES, lane = F.lane;
    const float qscale = 0.08838834764831845f;
    LAS float* av = (LAS float*)(F.lds + F.wave * 4096);
    for (int task = gw; task < 144; task += NGW) {
        const int cgp = task & 1, dir = (task >> 1) & 1, lb = task >> 2, blk = lb < 32 ? F.grp * 32 + lb : 256 + F.grp * 4 + (lb - 32);
        const bool lat = blk < 256;
        const int rowbase = lat ? (blk >> 5) * TL + (blk & 31) * 64 : ML + ((blk - 256) >> 2) * TC + ((blk - 256) & 3) * 64;
        const int c4 = cgp * 256 + lane * 4;
        { const float* ap = F.G32 + (size_t)(rowbase + (dir == 0 ? lane : 63 - lane)) * 32 + dir * 16;
#pragma unroll
          for (int r4 = 0; r4 < 4; ++r4) *(LAS f32x4*)(av + lane * 16 + r4 * 4) = *(const f32x4*)(ap + r4 * 4); }
        float w2r[16][4], bzv[4], run[4];
#pragma unroll
        for (int r = 0; r < 16; ++r) { const f32x4 w = *(const f32x4*)(A.in[18] + (size_t)(dir * 16 + r) * 512 + c4); w2r[r][0] = w.x; w2r[r][1] = w.y; w2r[r][2] = w.z; w2r[r][3] = w.w; }
        { const f32x4 w = *(const f32x4*)(A.in[19] + dir * 512 + c4); bzv[0] = w.x; bzv[1] = w.y; bzv[2] = w.z; bzv[3] = w.w; }
#pragma unroll
        for (int i = 0; i < 4; ++i) run[i] = 0.f;
        v2u qn[4], kn[4];
#pragma unroll
        for (int t = 0; t < 4; ++t) { const int row = rowbase + (dir == 0 ? t : 63 - t); qn[t] = *(const v2u*)(F.P16 + (size_t)row * PLD + c4); kn[t] = *(const v2u*)(F.P16 + (size_t)row * PLD + 512 + c4); }
        for (int jb = 0; jb < 16; ++jb) {
            v2u qc_[4], kc_[4];
#pragma unroll
            for (int t = 0; t < 4; ++t) { qc_[t] = qn[t]; kc_[t] = kn[t]; }
            if (jb < 15) {
#pragma unroll
                for (int t = 0; t < 4; ++t) { const int jj = (jb + 1) * 4 + t; const int row = rowbase + (dir == 0 ? jj : 63 - jj); qn[t] = *(const v2u*)(F.P16 + (size_t)row * PLD + c4); kn[t] = *(const v2u*)(F.P16 + (size_t)row * PLD + 512 + c4); } }
#pragma unroll
            for (int t = 0; t < 4; ++t) {
                const int jj = jb * 4 + t; const int row = rowbase + (dir == 0 ? jj : 63 - jj);
                float z[4] = {bzv[0], bzv[1], bzv[2], bzv[3]};
#pragma unroll
                for (int r4 = 0; r4 < 4; ++r4) { const f32x4 a4 = *(const LAS f32x4*)(av + jj * 16 + r4 * 4);
#pragma unroll
                    for (int i = 0; i < 4; ++i) z[i] += a4.x * w2r[r4 * 4][i] + a4.y * w2r[r4 * 4 + 1][i] + a4.z * w2r[r4 * 4 + 2][i] + a4.w * w2r[r4 * 4 + 3][i]; }
                const float qf[4] = {bflo(qc_[t].x), bfhi(qc_[t].x), bflo(qc_[t].y), bfhi(qc_[t].y)}, kf[4] = {bflo(kc_[t].x), bfhi(kc_[t].x), bflo(kc_[t].y), bfhi(kc_[t].y)};
                float oq[4], ok[4];
#pragma unroll
                for (int i = 0; i < 4; ++i) { run[i] += (fminf(z[i], 0.f) - __logf(1.0f + __expf(-fabsf(z[i])))) * 0.0625f; const float eg = __expf(run[i]); oq[i] = qf[i] * qscale * eg; ok[i] = kf[i] * __builtin_amdgcn_rcpf(eg); }
                bf16* dst = (lat ? QGl + (size_t)row * 2048 : QGc + (size_t)(row - ML) * 2048) + dir * 1024 + c4;
                v2u o1; o1.x = pk2(oq[0], oq[1]); o1.y = pk2(oq[2], oq[3]); *(v2u*)dst = o1;
                v2u o2; o2.x = pk2(ok[0], ok[1]); o2.y = pk2(ok[2], ok[3]); *(v2u*)(dst + 512) = o2;
            }
        }
        *(f32x4*)(EGL + (size_t)blk * 1024 + dir * 512 + c4) = (f32x4){__expf(run[0]), __expf(run[1]), __expf(run[2]), __expf(run[3])};
    }
}
__device__ __forceinline__ void gla_phase(Frame& F, const Args& A, const bf16* QGl, const bf16* QGc, const float* EGL) {
    const int tid = F.tid, lane = F.lane, wave = F.wave, fr = lane & 15, fq = lane >> 4;
    for (int task = F.vcu; task < 256; task += F.G) {
        const int eq = task & 3, dir = (task >> 2) & 1, h = (task >> 3) & 3, b = task >> 5;
        const int e0 = eq * 64;
        bf16* Oout = dir == 0 ? F.H16 : F.HB16;
        __syncthreads();
        for (int i = tid; i < 64 * 136 / 2; i += NTHR) ((LAS unsigned*)(F.lds + 88064))[i] = 0u;
        f32x4 st[4];
#pragma unroll
        for (int k = 0; k < 4; ++k) st[k] = (f32x4){0.f, 0.f, 0.f, 0.f};
        const int s = tid >> 3, cg = tid & 7;
        v4u rq0, rq1, rk0, rk1, rv0, rv1; float egn[4], egc[4];
#define GLA_LOAD(stepn) do { const bool ic_ = (stepn) < 4; const int c_ = ic_ ? (stepn) : (stepn) - 4, Tn_ = ic_ ? TC : TL; \
            const int t0_ = dir == 0 ? c_ * 64 : Tn_ - 64 * (c_ + 1), pos_ = dir == 0 ? t0_ + s : t0_ + 63 - s; \
            const bf16* qg_ = (ic_ ? QGc + (size_t)(b * TC + pos_) * 2048 : QGl + (size_t)(b * TL + pos_) * 2048) + dir * 1024 + h * 128 + cg * 16; \
            rq0 = *(const v4u*)(qg_); rq1 = *(const v4u*)(qg_ + 8); rk0 = *(const v4u*)(qg_ + 512); rk1 = *(const v4u*)(qg_ + 520); \
            if (cg < 4) { const bf16* pv_ = F.P16 + (size_t)((ic_ ? ML + b * TC : b * TL) + pos_) * PLD + 1024 + h * 256 + e0 + cg * 16; rv0 = *(const v4u*)(pv_); rv1 = *(const v4u*)(pv_ + 8); } \
            const int blk_ = ic_ ? 256 + b * 4 + (t0_ >> 6) : b * 32 + (t0_ >> 6); \
            _Pragma("unroll") for (int k_ = 0; k_ < 4; ++k_) egn[k_] = EGL[(size_t)blk_ * 1024 + dir * 512 + h * 128 + 16 * ((wave & 1) * 4 + k_) + fr]; } while (0)
        GLA_LOAD(0);
        for (int step = 0; step < 36; ++step) {
            const int p = step & 1;
            LAS bf16* Qg = (LAS bf16*)(F.lds + p * 44032);
            LAS bf16* Kg = (LAS bf16*)(F.lds + p * 44032 + 17408);
            LAS bf16* Vs = (LAS bf16*)(F.lds + p * 44032 + 34816);
            const LAS bf16* STr = (const LAS bf16*)(F.lds + 88064 + p * 17408);
            LAS bf16* STw = (LAS bf16*)(F.lds + 88064 + (p ^ 1) * 17408);
            const bool isctx = step < 4; const int c = isctx ? step : step - 4; const int Tn = isctx ? TC : TL;
            const int rowbase = isctx ? ML + b * TC : b * TL;
            const int t0 = dir == 0 ? c * 64 : Tn - 64 * (c + 1);
            *(LAS v4u*)(Qg + s * 136 + cg * 16) = rq0; *(LAS v4u*)(Qg + s * 136 + cg * 16 + 8) = rq1;
            *(LAS v4u*)(Kg + s * 136 + cg * 16) = rk0; *(LAS v4u*)(Kg + s * 136 + cg * 16 + 8) = rk1;
            if (cg < 4) { *(LAS v4u*)(Vs + s * 72 + cg * 16) = rv0; *(LAS v4u*)(Vs + s * 72 + cg * 16 + 8) = rv1; }
#pragma unroll
            for (int k = 0; k < 4; ++k) egc[k] = egn[k];
            if (step + 1 < 36) GLA_LOAD(step + 1);
            asm volatile("s_waitcnt lgkmcnt(0)" ::: "memory"); __builtin_amdgcn_s_barrier(); asm volatile("" ::: "memory");
            {
                const int jt = wave >> 1, ep = (wave & 1) * 2;
                bf16x8 qb[4];
#pragma unroll
                for (int ks = 0; ks < 4; ++ks) qb[ks] = ldfrag(Qg, 136, 16 * jt, 32 * ks, lane);
                f32x4 oT[2];
                {
                    bf16x8 sf[8];
#pragma unroll
                    for (int t2 = 0; t2 < 2; ++t2)
#pragma unroll
                        for (int ks = 0; ks < 4; ++ks) sf[t2 * 4 + ks] = ldfrag(STr, 136, 16 * (ep + t2), 32 * ks, lane);
                    PIN4(qb[0], qb[1], qb[2], qb[3]); PIN8(sf[0], sf[1], sf[2], sf[3], sf[4], sf[5], sf[6], sf[7]);
                    f32x4 o0 = {0.f, 0.f, 0.f, 0.f}, o1 = o0, o2 = o0, o3 = o0;
                    o0 = MFMA16(sf[0], qb[0], o0); o1 = MFMA16(sf[4], qb[0], o1); o2 = MFMA16(sf[1], qb[1], o2); o3 = MFMA16(sf[5], qb[1], o3);
                    o0 = MFMA16(sf[2], qb[2], o0); o1 = MFMA16(sf[6], qb[2], o1); o2 = MFMA16(sf[3], qb[3], o2); o3 = MFMA16(sf[7], qb[3], o3);
                    oT[0] = o0 + o2; oT[1] = o1 + o3;
                }
                for (int sp = 0; sp <= (jt >> 1); ++sp) {
                    const int ts0 = 2 * sp, ts1 = 2 * sp + 1;
                    bf16x8 kf[8];
#pragma unroll
                    for (int ks = 0; ks < 4; ++ks) { kf[ks] = ldfrag(Kg, 136, 16 * ts0, 32 * ks, lane); kf[4 + ks] = ldfrag(Kg, 136, 16 * ts1, 32 * ks, lane); }
                    bf16x8 vf0 = ldfrag_tr4(Vs, 72, 32 * sp, 16 * ep, lane), vf1 = ldfrag_tr4(Vs, 72, 32 * sp, 16 * (ep + 1), lane);
                    PIN8(kf[0], kf[1], kf[2], kf[3], kf[4], kf[5], kf[6], kf[7]); PIN2(vf0, vf1);
                    f32x4 aT0 = {0.f, 0.f, 0.f, 0.f}, aT1 = aT0, aT2 = aT0, aT3 = aT0;
                    aT0 = MFMA16(kf[0], qb[0], aT0); aT1 = MFMA16(kf[4], qb[0], aT1); aT2 = MFMA16(kf[1], qb[1], aT2); aT3 = MFMA16(kf[5], qb[1], aT3);
                    aT0 = MFMA16(kf[2], qb[2], aT0); aT1 = MFMA16(kf[6], qb[2], aT1); aT2 = MFMA16(kf[3], qb[3], aT2); aT3 = MFMA16(kf[7], qb[3], aT3);
                    aT0 = aT0 + aT2; aT1 = aT1 + aT3;
#pragma unroll
                    for (int reg = 0; reg < 4; ++reg) { const bool v0 = (ts0 < jt) || (4 * fq + reg <= fr), v1 = (ts1 < jt) || (ts1 == jt && 4 * fq + reg <= fr);
                        aT0[reg] = v0 ? aT0[reg] : 0.f; aT1[reg] = v1 ? aT1[reg] : 0.f; }
                    const bf16x8 pf = cvt8_mma(aT0[0], aT0[1], aT0[2], aT0[3], aT1[0], aT1[1], aT1[2], aT1[3]);
                    oT[0] = MFMA16(vf0, pf, oT[0]); oT[1] = MFMA16(vf1, pf, oT[1]);
                }
                const int jj = 16 * jt + fr; const int pos = dir == 0 ? t0 + jj : t0 + 63 - jj;
                bf16* op = Oout + (size_t)(rowbase + pos) * D + h * 256 + e0 + 4 * fq;
#pragma unroll
                for (int t2 = 0; t2 < 2; ++t2) { v2u w; w.x = pk2(oT[t2][0], oT[t2][1]); w.y = pk2(oT[t2][2], oT[t2][3]); *(v2u*)(op + 16 * (ep + t2)) = w; }
            }
            {
                const int et = wave >> 1;
                bf16x8 va0 = ldfrag_tr(Vs, 72, 0, 16 * et, lane), va1 = ldfrag_tr(Vs, 72, 32, 16 * et, lane);
                bf16x8 kb[8];
#pragma unroll
                for (int k = 0; k < 4; ++k) { const int dt = (wave & 1) * 4 + k; kb[2 * k] = ldfrag_tr(Kg, 136, 0, 16 * dt, lane); kb[2 * k + 1] = ldfrag_tr(Kg, 136, 32, 16 * dt, lane); }
                PIN2(va0, va1); PIN8(kb[0], kb[1], kb[2], kb[3], kb[4], kb[5], kb[6], kb[7]);
#pragma unroll
                for (int k = 0; k < 4; ++k) st[k] = MFMA16(va0, kb[2 * k], st[k]);
#pragma unroll
                for (int k = 0; k < 4; ++k) st[k] = MFMA16(va1, kb[2 * k + 1], st[k]);
#pragma unroll
                for (int k = 0; k < 4; ++k) { const int dt = (wave & 1) * 4 + k; st[k] = st[k] * egc[k];
#pragma unroll
                    for (int reg = 0; reg < 4; ++reg) STw[(16 * et + 4 * fq + reg) * 136 + 16 * dt + fr] = (bf16)f2bf(st[k][reg]); }
            }
        }
#undef GLA_LOAD
    }
}
__device__ __forceinline__ void gla_combine_phase(Frame& F, const Args& A, int nrows) {
    const int gw = F.mi * NWAVES + F.wave, NGW = 32 * NWAVES, nloc = nrows == MT ? TL + TC : TL;
    float ng[16];
#pragma unroll
    for (int i = 0; i < 16; ++i) ng[i] = A.in[20][(F.lane & 15) * 16 + i];
    for (int lr = gw; lr < nloc; lr += NGW) { const int row = grow(F, lr);
        bf16* of = F.H16 + (size_t)row * D + F.lane * 16; const bf16* ob = F.HB16 + (size_t)row * D + F.lane * 16; const bf16* rr = F.P16 + (size_t)row * PLD + 2048 + F.lane * 16;
        float o[16], a[8], b2[8]; float ss = 0.f;
#pragma unroll
        for (int hv = 0; hv < 2; ++hv) { unpack8(*(const v4u*)(of + hv * 8), a); unpack8(*(const v4u*)(ob + hv * 8), b2);
#pragma unroll
            for (int i = 0; i < 8; ++i) { o[hv * 8 + i] = a[i] + b2[i]; ss += o[hv * 8 + i] * o[hv * 8 + i]; } }
        ss += __shfl_xor(ss, 1); ss += __shfl_xor(ss, 2); ss += __shfl_xor(ss, 4); ss += __shfl_xor(ss, 8);
        const float rinv = 1.0f / sqrtf(ss * (1.f / 256.f) + EPS);
#pragma unroll
        for (int hv = 0; hv < 2; ++hv) { float g[8], y[8]; unpack8(*(const v4u*)(rr + hv * 8), g);
#pragma unroll
            for (int i = 0; i < 8; ++i) y[i] = o[hv * 8 + i] * rinv * ng[hv * 8 + i] * siluf_(g[i]);
            *(v4u*)(of + hv * 8) = pack8(y); }
    }
}

#define NA_SOFTMAX_PV(LOC_, VT_, S0_) do { \
        float sv[8]; float gmax = -INFINITY; \
        _Pragma("unroll") for (int t = 0; t < 2; ++t) _Pragma("unroll") for (int reg = 0; reg < 4; ++reg) { float x = (t == 0 ? sT0[reg] : sT1[reg]) * 0.125f; \
            if (LOC_) { const int col_k = kst + 16 * t + 4 * fq + reg; const bool valid = (col_k >= cst) && (col_k < cst + 16); \
                const int dc = min(max(col_k - col_q + 15, 0), 30), dr = rs + gi - r + 7; x = valid ? x + rpb[dr * 31 + dc] : -INFINITY; } \
            sv[t * 4 + reg] = x; gmax = fmaxf(gmax, x); } \
        gmax = fmaxf(gmax, __shfl_xor(gmax, 16)); gmax = fmaxf(gmax, __shfl_xor(gmax, 32)); \
        const float m_new = fmaxf(m_run, gmax), alpha = __expf(m_run - m_new); \
        float ps = 0.f; float pv[8]; \
        _Pragma("unroll") for (int i = 0; i < 8; ++i) { pv[i] = __expf(sv[i] - m_new); ps += pv[i]; } \
        l_part = l_part * alpha + ps; m_run = m_new; \
        const bf16x8 pf = cvt8_mma(pv[0], pv[1], pv[2], pv[3], pv[4], pv[5], pv[6], pv[7]); \
        _Pragma("unroll") for (int et = 0; et < 4; ++et) oT[et] = oT[et] * alpha; \
        oT[0] = MFMA16(vf0, pf, oT[0]); oT[1] = MFMA16(vf1, pf, oT[1]); oT[2] = MFMA16(vf2, pf, oT[2]); oT[3] = MFMA16(vf3, pf, oT[3]); } while (0)
__device__ __forceinline__ void na_phase(Frame& F, const Args& A) {
    LAS bf16* Vl = (LAS bf16*)(F.lds + 0);
    LAS bf16* Vc = (LAS bf16*)(F.lds + 82944);
    LAS bf16* Kc = (LAS bf16*)(F.lds + 119808);
    LAS float* rpb = (LAS float*)(F.lds + 156672);
    const int tid = F.tid, lane = F.lane, wave = F.wave, fr = lane & 15, fq = lane >> 4;
    const bf16* P = F.P16;
    for (int wg = F.vcu; wg < 256; wg += F.G) {
        const int bh = wg >> 1, b = bh >> 4, h = bh & 15, odd = wg & 1;
        __syncthreads();
        for (int it = tid; it < 256 * 8; it += NTHR) { const int tok = it >> 3, eg = it & 7; const bf16* src = P + (size_t)(ML + b * TC + tok) * PLD + h * 64 + eg * 8;
            *(LAS v4u*)(Vc + tok * 72 + eg * 8) = *(const v4u*)(src + 2048); *(LAS v4u*)(Kc + tok * 72 + eg * 8) = *(const v4u*)(src + 1024); }
        for (int i = tid; i < 465; i += NTHR) rpb[i] = A.in[23][h * 465 + i];
        int have_hi = -1;
        for (int si = 0; si < 9; ++si) { const int sub = si < 8 ? odd * 8 + si : 16 + odd;
            const bool lat = sub < 16;
            const int rp = lat ? sub : 0, half = lat ? 0 : sub - 16;
            const int r0 = 2 * rp, rs0 = min(max(r0 - 4, 0), 24), nrw = min(9, 32 - rs0);
            const int r = r0 + (wave >> 2), n = wave & 3;
            const int rs = min(max(r - 4, 0), 24), kst = min(max(16 * n - 8, 0), 32);
            const int qrow = lat ? b * TL + r * 64 + 16 * n + fr : ML + b * TC + 16 * (half * 8 + wave) + fr;
            const bf16x8 qf0 = *(const bf16x8*)(P + (size_t)qrow * PLD + h * 64 + 8 * fq), qf1 = *(const bf16x8*)(P + (size_t)qrow * PLD + h * 64 + 32 + 8 * fq);
            bf16x8 ka[4], kb[4];
#define NA_KLOAD(kd_, gi_) do { const bf16* kp_ = P + (size_t)(b * TL + (rs + (gi_)) * 64 + kst + fr) * PLD + 1024 + h * 64 + 8 * fq; \
                    kd_[0] = *(const bf16x8*)(kp_); kd_[1] = *(const bf16x8*)(kp_ + 32); kd_[2] = *(const bf16x8*)(kp_ + (size_t)16 * PLD); kd_[3] = *(const bf16x8*)(kp_ + (size_t)16 * PLD + 32); } while (0)
            if (lat) { NA_KLOAD(ka, 0); NA_KLOAD(kb, 1); }
            asm volatile("s_waitcnt lgkmcnt(0)" ::: "memory"); __builtin_amdgcn_s_barrier(); asm volatile("" ::: "memory");
            if (lat) {
                const int lo = have_hi < 0 ? rs0 : max(rs0, have_hi), hi = rs0 + nrw;
                for (int it = tid; it < (hi - lo) * 64 * 8; it += NTHR) { const int rw = lo + (it >> 9), tk = (it >> 3) & 63, eg = it & 7;
                    *(LAS v4u*)(Vl + ((rw % 9) * 64 + tk) * 72 + eg * 8) = *(const v4u*)(P + (size_t)(b * TL + rw * 64 + tk) * PLD + 2048 + h * 64 + eg * 8); }
                have_hi = hi;
            }
            asm volatile("s_waitcnt lgkmcnt(0)" ::: "memory"); __builtin_amdgcn_s_barrier(); asm volatile("" ::: "memory");
            const int col_q = 16 * n + fr, cst = min(max(col_q - 8, 0), 48);
            float m_run = -INFINITY, l_part = 0.f;
            f32x4 oT[4];
#pragma unroll
            for (int et = 0; et < 4; ++et) oT[et] = (f32x4){0.f, 0.f, 0.f, 0.f};
            if (lat) {
#define NA_WGROUP(kd_, gi_) do { const int gi = (gi_); const bf16x8 k00 = kd_[0], k01 = kd_[1], k10 = kd_[2], k11 = kd_[3]; \
                    if (gi + 2 < 8) NA_KLOAD(kd_, gi + 2); \
                    const int s0 = ((rs + gi) % 9) * 64 + kst; \
                    bf16x8 vf0 = ldfrag_tr4(Vl, 72, s0, 0, lane), vf1 = ldfrag_tr4(Vl, 72, s0, 16, lane), vf2 = ldfrag_tr4(Vl, 72, s0, 32, lane), vf3 = ldfrag_tr4(Vl, 72, s0, 48, lane); \
                    f32x4 sT0 = {0.f, 0.f, 0.f, 0.f}, sT1 = sT0; \
                    sT0 = MFMA16(k00, qf0, sT0); sT1 = MFMA16(k10, qf0, sT1); sT0 = MFMA16(k01, qf1, sT0); sT1 = MFMA16(k11, qf1, sT1); \
                    NA_SOFTMAX_PV(true, Vl, s0); } while (0)
#pragma unroll 1
                for (int g2 = 0; g2 < 8; g2 += 2) { NA_WGROUP(ka, g2); NA_WGROUP(kb, g2 + 1); }
#undef NA_WGROUP
#undef NA_KLOAD
            }
#pragma unroll 1
            for (int gc = 0; gc < 8; ++gc) {
                const int gi = 8 + gc; (void)gi;
                bf16x8 k00 = ldfrag(Kc, 72, 32 * gc, 0, lane), k01 = ldfrag(Kc, 72, 32 * gc, 32, lane), k10 = ldfrag(Kc, 72, 32 * gc + 16, 0, lane), k11 = ldfrag(Kc, 72, 32 * gc + 16, 32, lane);
                bf16x8 vf0 = ldfrag_tr4(Vc, 72, 32 * gc, 0, lane), vf1 = ldfrag_tr4(Vc, 72, 32 * gc, 16, lane), vf2 = ldfrag_tr4(Vc, 72, 32 * gc, 32, lane), vf3 = ldfrag_tr4(Vc, 72, 32 * gc, 48, lane);
                PIN4(k00, k01, k10, k11);
                f32x4 sT0 = {0.f, 0.f, 0.f, 0.f}, sT1 = sT0;
                sT0 = MFMA16(k00, qf0, sT0); sT1 = MFMA16(k10, qf0, sT1); sT0 = MFMA16(k01, qf1, sT0); sT1 = MFMA16(k11, qf1, sT1);
                NA_SOFTMAX_PV(false, Vc, 0);
            }
            float l = l_part; l += __shfl_xor(l, 16); l += __shfl_xor(l, 32);
            const float inv = 1.0f / l;
            bf16* op = F.H16 + (size_t)qrow * D + h * 64 + 4 * fq;
#pragma unroll
            for (int et = 0; et < 4; ++et) { v2u w; w.x = pg8::cvt_pk_bf16(oT[et][0] * inv, oT[et][1] * inv); w.y = pg8::cvt_pk_bf16(oT[et][2] * inv, oT[et][3] * inv); *(v2u*)(op + 16 * et) = w; }
        }
    }
}
constexpr int N_PHASES = 42;

#ifndef STAG
#define STAG 1
#endif
#ifndef SLP
#define SLP 64
#endif
#ifndef GSTAG
#define GSTAG 0
#endif
template <class Epi, bool SWAP>
__device__ __forceinline__ void run_gemm(Frame& F, const bf16* A, const bf16* Bt, int npan, int N, int K, const Epi& E) {
    pg8::Gemm g{A, Bt, MT, N, K}; GroupOrder S; S.g = F.grp; S.mi = F.mi; S.npan = npan; S.nN = N / 256; S.ntK = K / 64; S.wid = F.wave;
    if (STAG) {
        const int rem = (npan * (N / 256)) % 32;
        if (rem != 0 && F.mi >= rem) { const int st = ((F.mi - rem) & 3) + 1; for (int i = 0; i < st * STAG; ++i) __builtin_amdgcn_s_sleep(SLP); }
    }
    pg8::gemm_phase<Epi, GroupOrder, true, true, SWAP>(F.lds, g, S, E);
}
__device__ __forceinline__ void run_resid_gemm(Frame& F, const bf16* A, const bf16* Bt, int K, bool with_ctx, const float* gate, float* slab) {
    pg8::Gemm g{A, Bt, MT, D, K}; GroupSplitOrder S; S.g = F.grp; S.mi = F.mi; S.ntK = K / 64; S.np = with_ctx ? 16 : 0; S.wid = F.wave; EpiResidSplit E{F.X, gate, slab, 0};
    pg8::gemm_phase<EpiResidSplit, GroupSplitOrder, true, true, false>(F.lds, g, S, E);
}
__global__ void __launch_bounds__(NTHR, 2) fwd_kernel(Args args) {
    extern __shared__ __attribute__((aligned(16))) unsigned char lds_raw[];
    Frame F;
    F.lds = (LAS unsigned char*)lds_raw;
    F.wave = __builtin_amdgcn_readfirstlane((int)threadIdx.x >> 6); F.lane = lane_id_now(); F.tid = F.wave * 64 + F.lane;
    F.G = gridDim.x; { const int bx = blockIdx.x; F.vcu = (bx % 8) * 32 + bx / 8; }
    F.grp = F.vcu >> 5; F.mi = F.vcu & 31; F.gph = 0u;
    F.ws = args.ws;
    F.X = (bf16*)(args.ws + WS_X); F.H16 = (bf16*)(args.ws + WS_H16); F.HB16 = (bf16*)(args.ws + WS_HB16); F.P16 = (bf16*)(args.ws + WS_P16);
    F.G32 = (float*)(args.ws + WS_G32); F.EDGE = (float*)(args.ws + WS_EDGE); F.MOD = (float*)(args.ws + WS_MOD);
    volatile LAS unsigned* MISC = (volatile LAS unsigned*)(F.lds + MISC_OFF);
    for (int u = F.tid; u < 128; u += NTHR) MISC[u] = 0u;
    __syncthreads();
    unsigned* bw = (unsigned*)(args.ws + WS_CTL) + 4096;
    XcdBarrier bar = xcd_barrier_post(bw, MISC + 8, F.wave == 0);
#define GSEAM() do { F.lane = lane_id_now(); F.tid = F.wave * 64 + F.lane; grp_barrier(bw, F.grp, F.gph, F.tid, F.same_l2); } while (0)
#define GSEAMF(fw_, fc_) do { F.lane = lane_id_now(); F.tid = F.wave * 64 + F.lane; grp_barrier(bw, F.grp, F.gph, F.tid, F.same_l2, (fw_), (fc_)); } while (0)
#define RELANE() do { F.lane = lane_id_now(); F.tid = F.wave * 64 + F.lane; } while (0)

    if (F.tid == 0) __hip_atomic_store(&bw[GB_XID(F.vcu)], xb_xcc_id() + 1u, __ATOMIC_RELAXED, __HIP_MEMORY_SCOPE_AGENT);
    convert_layer_weights(F, args, 0, F.vcu * NWAVES + F.wave, F.G * NWAVES, 1); p0_adaln(F, args, 0, F.vcu, F.G);
    xcd_barrier(bar);
    { const unsigned v = xb_ld(&bw[GB_XID(F.grp * 32 + (lane_id_now() & 31))]); F.same_l2 = __all(v == xb_xcc_id() + 1u) != 0; }
    for (int i = 0; i < F.grp * GSTAG; ++i) __builtin_amdgcn_s_sleep(SLP);

    float* slab = (float*)(args.ws + WS_SLAB); float* EGL = (float*)(args.ws + WS_EGL);
    for (int layer = 0; layer < DEPTH; ++layer) {
        RELANE();
        const int kind = layer % 3, jk = layer / 3;
        const bool last = layer == DEPTH - 1;
        const int Mff = last ? ML : MT, npan = last ? 8 : 9;
        const float* modl = F.MOD + (size_t)layer * 9 * 6144;
        const int nN_in = kind == 2 ? 12 : 13;
        RELANE(); norm_phase(F, args, layer, 0, layer == 0, MT, layer > 0 ? slab : nullptr, F.MOD + (size_t)((layer > 0 ? layer - 1 : 0) * 9 + 8) * 6144 + 5120);
        if (layer > 0) GSEAMF(FL_W(layer), 8u * (unsigned)(32 - (9 * 22) % 32)); else GSEAM();
        { RELANE();
            EpiInproj E{F.P16, F.G32};
            run_gemm<EpiInproj, false>(F, F.H16, wb_ptr(F, layer, WB_IN), 9, nN_in * 256, D, E);
            if (!last) {
                const int rem = (9 * nN_in) % 32, nidle = rem == 0 ? 32 : 32 - rem, iidx = rem == 0 ? F.mi : F.mi - rem;
                if (iidx >= 0) { p0_adaln(F, args, layer + 1, F.grp * nidle + iidx, 8 * nidle); flag_signal(bw, FL_M(layer + 1), F.tid); }
            }
            GSEAM();
        }
        bf16* QKl = kind == 0 ? (bf16*)args.out + (size_t)F.grp * TL * D : (bf16*)args.out;
        bf16* QKc = (bf16*)(args.ws + WS_SCR);
        if (kind == 0) { RELANE(); mlstm_prep_phase(F, args, jk, QKl, QKc); GSEAM(); }
        else if (kind == 1) { RELANE(); gla_prep_phase(F, args, QKl, QKc, EGL); GSEAM(); }
        { RELANE();
            if (kind == 0) mlstm_phase(F, args, jk, QKl, QKc, (f32x4*)(args.ws + WS_GATES));
            else if (kind == 1) gla_phase(F, args, QKl, QKc, EGL);
            else na_phase(F, args);
            if (layer == 0) { RELANE(); __syncthreads(); convert_layer_weights(F, args, 0, F.vcu * NWAVES + F.wave, F.G * NWAVES, 2); flag_signal(bw, FL_W2, F.tid); }
            GSEAM();
        }
        if (kind == 0) { RELANE(); mlstm_combine_phase(F, args, Mff); GSEAM(); }
        else if (kind == 1) { RELANE(); gla_combine_phase(F, args, Mff); GSEAM(); }
        { RELANE(); run_resid_gemm(F, F.H16, wb_ptr(F, layer, WB_OUT), D, !last, modl + 2048, slab); GSEAM(); }
        { RELANE(); norm_phase(F, args, layer, 1, false, Mff, last ? nullptr : slab, modl + (size_t)8 * 6144 + 2048); if (layer == 0) GSEAMF(FL_W2, 256u); else GSEAM(); }
        { RELANE();
            EpiConvGate E{F.P16, F.EDGE, args.in[9] + (size_t)layer * 3 * FF2, args.in[10] + (size_t)layer * FF2, (LAS float*)(F.lds + CE_OFF)};
            run_gemm<EpiConvGate, true>(F, F.H16, wb_ptr(F, layer, WB_UP), npan, FF2, D, E);
            if (!last) {
                const int rem = (npan * 22) % 32, nidle = rem == 0 ? 32 : 32 - rem, iidx = rem == 0 ? F.mi : F.mi - rem;
                if (iidx >= 0) { convert_layer_weights(F, args, layer + 1, (F.grp * nidle + iidx) * NWAVES + F.wave, 8 * nidle * NWAVES, 0); flag_signal(bw, FL_W(layer + 1), F.tid); }
            }
            GSEAM();
        }
        { RELANE(); ffn_fixup_phase(F, args, layer); GSEAM(); }
        { RELANE(); run_resid_gemm(F, F.P16, wb_ptr(F, layer, WB_DN), FF, !last, modl + 5120, slab);
            if (!last) { const int pu = 9 * nN_in, prem = pu % 32; GSEAMF(FL_M(layer + 1), 8u * (unsigned)(prem == 0 ? 32 : 32 - prem)); }
            else GSEAM(); }
    }
    RELANE(); final_norm_phase(F, args);
#undef GSEAM
#undef RELANE
}

#ifndef MK_PER_PHASE
#define MK_PER_PHASE 0
#endif
extern "C" void kernel_launch(void* const* d_in, const int* in_sizes, int n_in, void* d_out, int out_size, void* d_ws, size_t ws_size, hipStream_t stream) {
    static int grid = 0;
    if (grid == 0) {
        if (n_in != 26 || out_size != ML * D || ws_size < WS_END) { fprintf(stderr, "kernel_launch: unexpected shapes: n_in %d out %d ws %zu (need %zu)\n", n_in, out_size, ws_size, (size_t)WS_END); grid = -1; return; }
        int dev = 0, cus = 0, per_cu = 0;
        if (hipGetDevice(&dev) != hipSuccess || hipDeviceGetAttribute(&cus, hipDeviceAttributeMultiprocessorCount, dev) != hipSuccess) { grid = -1; return; }
        if (hipFuncSetAttribute((const void*)fwd_kernel, hipFuncAttributeMaxDynamicSharedMemorySize, LDS_BYTES) != hipSuccess) { fprintf(stderr, "kernel_launch: hipFuncSetAttribute failed\n"); grid = -1; return; }
        if (hipOccupancyMaxActiveBlocksPerMultiprocessor(&per_cu, (const void*)fwd_kernel, NTHR, LDS_BYTES) != hipSuccess || per_cu < 1) { fprintf(stderr, "kernel_launch: occupancy query failed (%d)\n", per_cu); (void)hipGetLastError(); grid = -1; return; }
        if (cus < 256) { fprintf(stderr, "kernel_launch: needs 256 compute units (8 batch groups of 32 workgroups), found %d\n", cus); grid = -1; return; }
        grid = 256;
        fprintf(stderr, "kernel_launch: grid %d (cus %d, occupancy %d per CU)\n", grid, cus, per_cu);
    }
    if (grid < 0) return;
    if (hipMemsetAsync((char*)d_ws + WS_CTL, 0, CTL_ZERO_BYTES, stream) != hipSuccess) return;
    Args a{};
    for (int i = 0; i < 26; ++i) a.in[i] = (const float*)d_in[i];
    a.out = (float*)d_out; a.ws = (unsigned char*)d_ws;
#if 0
#else
    a.ph_lo = 0; a.ph_hi = N_PHASES;
#ifdef MK_PLAIN_LAUNCH
    hipLaunchKernelGGL(fwd_kernel, dim3(grid), dim3(NTHR), LDS_BYTES, stream, a);
#else
    void* kargs[] = {&a};
    hipError_t e = hipLaunchCooperativeKernel((const void*)fwd_kernel, dim3(grid), dim3(NTHR), kargs, LDS_BYTES, stream);
    if (e != hipSuccess) fprintf(stderr, "kernel_launch: cooperative launch failed: %s (grid %d)\n", hipGetErrorString(e), grid);
#endif
#endif
}
```
